# Optimizing an MI355X kernel written in HIP

```python
import math
import jax, jax.numpy as jnp
from jax import lax
import numpy as np

D_MODEL = 1024
BATCH = 4
SEQ = 4096
DEPTH = 4

N_MEM = 256
MEM_HEADS = 4
MEM_HEAD_DIM = 64
MEM_WIDTH = MEM_HEADS * MEM_HEAD_DIM
SSM_WIDTH = D_MODEL // 2
MLA_WIDTH = D_MODEL // 2
MIX_WIDTH = SSM_WIDTH + MLA_WIDTH
SSM_GROUP = 16
SSM_GROUPS = SSM_WIDTH // SSM_GROUP
SSM_STATE = 64
MLA_HEADS = 8
QK_NOPE = 64
QK_ROPE = 32
QK_DIM = QK_NOPE + QK_ROPE
V_DIM = MLA_WIDTH // MLA_HEADS
Q_LORA = 256
KV_LORA = 128
ROPE_THETA = 10000.0
Q_BLOCK = 128
D_FF = 4 * D_MODEL
IN_COLS = SSM_WIDTH + Q_LORA + KV_LORA + QK_ROPE
EPS = 1e-6

kernel_name = 'hymba_s5_mla_memory_trunk'


def rms_norm(x, gain):
    xf = x.astype(jnp.float32)
    y = xf * lax.rsqrt(jnp.mean(xf * xf, axis=-1, keepdims=True) + EPS)
    return y.astype(x.dtype) * gain


def rope(x, positions):
    half = QK_ROPE // 2
    inv_freq = ROPE_THETA ** (-jnp.arange(half, dtype=jnp.float32) / half)
    ang = positions.astype(jnp.float32)[..., None] * inv_freq
    ang = ang.reshape(ang.shape[:2] + (1,) * (x.ndim - 3) + (half,))
    cos = jnp.cos(ang).astype(x.dtype)
    sin = jnp.sin(ang).astype(x.dtype)
    x1, x2 = x[..., :half], x[..., half:]
    return jnp.concatenate([x1 * cos - x2 * sin, x2 * cos + x1 * sin], axis=-1)


def s5_mixer(u, lam_re, lam_im, log_step, b_re, b_im, c_re, c_im, d, w_glu, b_glu):
    bsz, seq, _ = u.shape
    f32 = jnp.float32
    uf = u.astype(f32).reshape(bsz, seq, SSM_GROUPS, SSM_GROUP)
    lam = lax.complex(lam_re.astype(f32), lam_im.astype(f32))
    step = jnp.exp(log_step.astype(f32))[:, None]
    a_bar = jnp.exp(lam * step)
    b = lax.complex(b_re.astype(f32), b_im.astype(f32))
    b_bar = ((a_bar - 1.0) / lam)[..., None] * b
    c = lax.complex(c_re.astype(f32), c_im.astype(f32))
    bu = jnp.einsum('gph,bsgh->bsgp', b_bar, uf.astype(jnp.complex64))
    a_seq = jnp.broadcast_to(a_bar, bu.shape)

    def combine(e1, e2):
        a1, s1 = e1
        a2, s2 = e2
        return a2 * a1, a2 * s1 + s2

    _, states = lax.associative_scan(combine, (a_seq, bu), axis=1)
    y = jnp.einsum('ghp,bsgp->bsgh', c, states).real + d.astype(f32).reshape(SSM_GROUPS, SSM_GROUP) * uf
    y = jax.nn.gelu(y.reshape(bsz, seq, SSM_WIDTH)).astype(u.dtype)
    return y * jax.nn.sigmoid(y @ w_glu + b_glu)


def causal_block_attention(q, k, v):
    bsz, seq, heads, dq = q.shape
    n_blocks = seq // Q_BLOCK
    scale = 1.0 / math.sqrt(dq)
    qb = q.reshape(bsz, n_blocks, Q_BLOCK, heads, dq).transpose(1, 0, 3, 2, 4)
    kt = k.transpose(0, 2, 1, 3)
    vt = v.transpose(0, 2, 1, 3)
    k_pos = jnp.arange(seq)

    def block(args):
        q_blk, blk = args
        s = jnp.einsum('bhqd,bhkd->bhqk', q_blk, kt).astype(jnp.float32) * scale
        q_pos = blk * Q_BLOCK + jnp.arange(Q_BLOCK)
        s = jnp.where(k_pos[None, :] <= q_pos[:, None], s, -jnp.inf)
        p = jax.nn.softmax(s, axis=-1).astype(vt.dtype)
        return jnp.einsum('bhqk,bhkd->bhqd', p, vt)

    o = lax.map(block, (qb, jnp.arange(n_blocks)))
    return o.transpose(1, 0, 3, 2, 4).reshape(bsz, seq, heads, v.shape[-1])


def mla_mixer(c_q, c_kv, k_rope, positions, q_norm, w_uq, kv_norm, w_ukv, q_gain, k_gain):
    bsz, seq, _ = c_q.shape
    q = (rms_norm(c_q, q_norm) @ w_uq).reshape(bsz, seq, MLA_HEADS, QK_DIM)
    kv = (rms_norm(c_kv, kv_norm) @ w_ukv).reshape(bsz, seq, MLA_HEADS, QK_NOPE + V_DIM)
    k_nope, v = kv[..., :QK_NOPE], kv[..., QK_NOPE:]
    k_pe = jnp.broadcast_to(k_rope[:, :, None, :], (bsz, seq, MLA_HEADS, QK_ROPE))
    k = jnp.concatenate([k_nope, k_pe], axis=-1)
    q = rms_norm(q, q_gain)
    k = rms_norm(k, k_gain)
    q = jnp.concatenate([q[..., :QK_NOPE], rope(q[..., QK_NOPE:], positions)], axis=-1)
    k = jnp.concatenate([k[..., :QK_NOPE], rope(k[..., QK_NOPE:], positions)], axis=-1)
    out = causal_block_attention(q, k, v)
    return out.reshape(bsz, seq, MLA_WIDTH)


def memory_cross_attention(h, mem_h, w_q, w_kv, q_gain, k_gain, w_o):
    bsz, seq, _ = h.shape
    n_mem = mem_h.shape[1]
    q = (h @ w_q).reshape(bsz, seq, MEM_HEADS, MEM_HEAD_DIM)
    kv = (mem_h @ w_kv).reshape(bsz, n_mem, MEM_HEADS, 2 * MEM_HEAD_DIM)
    k, v = kv[..., :MEM_HEAD_DIM], kv[..., MEM_HEAD_DIM:]
    q = rms_norm(q, q_gain)
    k = rms_norm(k, k_gain)
    s = jnp.einsum('bqhd,bkhd->bhqk', q, k).astype(jnp.float32) / math.sqrt(MEM_HEAD_DIM)
    p = jax.nn.softmax(s, axis=-1).astype(v.dtype)
    o = jnp.einsum('bhqk,bkhd->bqhd', p, v).reshape(bsz, seq, MEM_WIDTH)
    return o @ w_o


def setup_inputs(seed: int = 0) -> dict:
    key = jax.random.key(seed)
    ks = jax.random.split(key, 40)
    f32 = jnp.float32

    def nrm(k, shape, scale):
        return jax.random.normal(k, shape, f32) * scale

    def gain(k, shape):
        return 1.0 + 0.01 * jax.random.normal(k, shape, f32)

    L = DEPTH
    G, P, H = SSM_GROUPS, SSM_STATE, SSM_GROUP
    lam_im = jnp.broadcast_to(jnp.pi * jnp.arange(P, dtype=f32), (L, G, P)) + 0.01 * jax.random.normal(ks[4], (L, G, P), f32)
    lam_re = -0.5 + 0.01 * jax.random.normal(ks[3], (L, G, P), f32)
    log_step = jax.random.uniform(ks[5], (L, G), f32, math.log(1e-3), math.log(1e-1))
    return {
        'x': jax.random.normal(ks[0], (BATCH, SEQ, D_MODEL), f32),
        'mem': jax.random.normal(ks[1], (BATCH, N_MEM, D_MODEL), f32),
        'positions': jnp.broadcast_to(jnp.arange(SEQ, dtype=jnp.int32), (BATCH, SEQ)),
        'norm_mix': gain(ks[2], (L, D_MODEL)),
        'w_in': nrm(ks[6], (L, D_MODEL, IN_COLS), D_MODEL ** -0.5),
        'ssm_lambda_re': lam_re,
        'ssm_lambda_im': lam_im,
        'ssm_log_step': log_step,
        'ssm_b_re': nrm(ks[7], (L, G, P, H), (2 * H) ** -0.5),
        'ssm_b_im': nrm(ks[8], (L, G, P, H), (2 * H) ** -0.5),
        'ssm_c_re': nrm(ks[9], (L, G, H, P), (2 * P) ** -0.5),
        'ssm_c_im': nrm(ks[10], (L, G, H, P), (2 * P) ** -0.5),
        'ssm_d': nrm(ks[11], (L, SSM_WIDTH), 1.0),
        'ssm_w_glu': nrm(ks[12], (L, SSM_WIDTH, SSM_WIDTH), SSM_WIDTH ** -0.5),
        'ssm_b_glu': nrm(ks[13], (L, SSM_WIDTH), 0.02),
        'mla_q_norm': gain(ks[14], (L, Q_LORA)),
        'mla_w_uq': nrm(ks[15], (L, Q_LORA, MLA_HEADS * QK_DIM), Q_LORA ** -0.5),
        'mla_kv_norm': gain(ks[16], (L, KV_LORA)),
        'mla_w_ukv': nrm(ks[17], (L, KV_LORA, MLA_HEADS * (QK_NOPE + V_DIM)), KV_LORA ** -0.5),
        'mla_q_gain': gain(ks[18], (L, QK_DIM)),
        'mla_k_gain': gain(ks[19], (L, QK_DIM)),
        'out_norm_ssm': gain(ks[20], (L, SSM_WIDTH)),
        'out_norm_mla': gain(ks[21], (L, MLA_WIDTH)),
        'w_out': nrm(ks[22], (L, MIX_WIDTH, D_MODEL), MIX_WIDTH ** -0.5),
        'norm_mem_q': gain(ks[23], (L, D_MODEL)),
        'norm_mem_kv': gain(ks[24], (L, D_MODEL)),
        'mem_w_q': nrm(ks[25], (L, D_MODEL, MEM_WIDTH), D_MODEL ** -0.5),
        'mem_w_kv': nrm(ks[26], (L, D_MODEL, 2 * MEM_WIDTH), D_MODEL ** -0.5),
        'mem_q_gain': gain(ks[27], (L, MEM_HEAD_DIM)),
        'mem_k_gain': gain(ks[28], (L, MEM_HEAD_DIM)),
        'mem_w_o': nrm(ks[29], (L, MEM_WIDTH, D_MODEL), MEM_WIDTH ** -0.5),
        'norm_mlp': gain(ks[30], (L, D_MODEL)),
        'mlp_w1': nrm(ks[31], (L, D_MODEL, D_FF), D_MODEL ** -0.5),
        'mlp_w2': nrm(ks[32], (L, D_FF, D_MODEL), D_FF ** -0.5),
    }


def reference(x, mem, positions, norm_mix, w_in,
              ssm_lambda_re, ssm_lambda_im, ssm_log_step, ssm_b_re, ssm_b_im,
              ssm_c_re, ssm_c_im, ssm_d, ssm_w_glu, ssm_b_glu,
              mla_q_norm, mla_w_uq, mla_kv_norm, mla_w_ukv, mla_q_gain, mla_k_gain,
              out_norm_ssm, out_norm_mla, w_out,
              norm_mem_q, norm_mem_kv, mem_w_q, mem_w_kv, mem_q_gain, mem_k_gain, mem_w_o,
              norm_mlp, mlp_w1, mlp_w2):
    s1 = SSM_WIDTH
    s2 = s1 + Q_LORA
    s3 = s2 + KV_LORA
    for l in range(DEPTH):
        h = rms_norm(x, norm_mix[l])
        proj = h @ w_in[l]
        u, c_q, c_kv, k_rope = proj[..., :s1], proj[..., s1:s2], proj[..., s2:s3], proj[..., s3:]
        y_ssm = s5_mixer(u, ssm_lambda_re[l], ssm_lambda_im[l], ssm_log_step[l],
                         ssm_b_re[l], ssm_b_im[l], ssm_c_re[l], ssm_c_im[l],
                         ssm_d[l], ssm_w_glu[l], ssm_b_glu[l])
        y_mla = mla_mixer(c_q, c_kv, k_rope, positions, mla_q_norm[l], mla_w_uq[l],
                          mla_kv_norm[l], mla_w_ukv[l], mla_q_gain[l], mla_k_gain[l])
        y = jnp.concatenate([rms_norm(y_ssm, out_norm_ssm[l]), rms_norm(y_mla, out_norm_mla[l])], axis=-1)
        x = x + y @ w_out[l]
        x = x + memory_cross_attention(rms_norm(x, norm_mem_q[l]), rms_norm(mem, norm_mem_kv[l]),
                                       mem_w_q[l], mem_w_kv[l], mem_q_gain[l], mem_k_gain[l], mem_w_o[l])
        h = rms_norm(x, norm_mlp[l])
        x = x + jnp.square(jax.nn.relu(h @ mlp_w1[l])) @ mlp_w2[l]
    return x
```

```cpp
#include <hip/hip_runtime.h>
#include <hip/hip_cooperative_groups.h>
#include <cstdio>
#include <cstdint>
namespace cg = cooperative_groups;

#ifndef MK_PER_PHASE
#define MK_PER_PHASE 0
#endif

typedef unsigned short bf16_t;
typedef short bf16x8 __attribute__((ext_vector_type(8)));
typedef short bf16x4 __attribute__((ext_vector_type(4)));
typedef float f32x4 __attribute__((ext_vector_type(4)));
typedef unsigned u32x2 __attribute__((ext_vector_type(2)));
typedef unsigned u32x4 __attribute__((ext_vector_type(4)));

constexpr int DEPTH = 4, BATCH = 4, SEQ = 4096, DM = 1024, T_ = BATCH * SEQ;
constexpr int NMEM = 256, MEMH = 4, MEMHD = 64, MEMW = 256;
constexpr int SSMW = 512, NGRP = 32, SGRP = 16, SST = 64;
constexpr int MLAH = 8, QKN = 64, QKR = 32, QKD = 96, VD = 64, QLORA = 256, KVLORA = 128;
constexpr int DFF = 4096, INCOLS = 928, INPAD = 960;
constexpr float EPS = 1e-6f;
constexpr float LOG2E = 1.4426950408889634f;
constexpr int CH = 16;
constexpr int NCH = SEQ / CH;

enum { I_X = 0, I_MEM, I_POS, I_NORM_MIX, I_W_IN, I_LAM_RE, I_LAM_IM, I_LOG_STEP, I_B_RE, I_B_IM, I_C_RE, I_C_IM, I_SSM_D, I_W_GLU, I_B_GLU,
       I_Q_NORM, I_W_UQ, I_KV_NORM, I_W_UKV, I_Q_GAIN, I_K_GAIN, I_ON_SSM, I_ON_MLA, I_W_OUT, I_NMEM_Q, I_NMEM_KV, I_MEM_WQ, I_MEM_WKV,
       I_MEM_QG, I_MEM_KG, I_MEM_WO, I_NORM_MLP, I_W1, I_W2, N_IN };

constexpr size_t MiB = 1u << 20;
constexpr size_t WS_ROPE_COS = 1 * MiB, WS_ROPE_SIN = 2 * MiB;
constexpr size_t WS_MEMB = 3 * MiB;
constexpr size_t WS_KMEM = 5 * MiB;
constexpr size_t WS_VMEMT = 5 * MiB + 512 * 1024;
constexpr size_t WS_KTAB = 6 * MiB;
constexpr size_t WS_WE = 7 * MiB;
constexpr size_t WS_WY = 15 * MiB;
constexpr size_t WS_A16 = 23 * MiB;
constexpr size_t WS_WBUF = 24 * MiB;
constexpr size_t WBUF_BYTES = 23 * MiB;
constexpr size_t WS_XB = 70 * MiB;
constexpr size_t WS_R = 102 * MiB;
constexpr size_t WS_U = WS_R, WS_CQ = WS_R + 16 * MiB, WS_CKV = WS_R + 24 * MiB;
constexpr size_t WS_Q = WS_R + 30 * MiB, WS_K = WS_R + 54 * MiB, WS_VT = WS_R + 78 * MiB;
constexpr size_t WS_E = WS_R + 94 * MiB;
constexpr size_t WS_YMLA = WS_R + 110 * MiB;
constexpr size_t WS_YG = WS_Q;
constexpr size_t WS_YSSM = WS_K;
constexpr size_t WS_MQ = WS_R, WS_O = WS_R + 8 * MiB;
constexpr size_t WS_HB = WS_R;
constexpr size_t WS_END = WS_R + 128 * MiB;
constexpr int CKVP = 160;

constexpr size_t OW_IN = 0, OW_GLU = OW_IN + (size_t)INPAD * 1024, OW_UQ = OW_GLU + 512 * 512, OW_UKV = OW_UQ + 768 * 256, OW_OUT = OW_UKV + 1024 * 128,
                 OW_MQ = OW_OUT + 1024 * 1024, OW_MKV = OW_MQ + 256 * 1024, OW_MO = OW_MKV + 512 * 1024, OW_1 = OW_MO + 1024 * 256, OW_2 = OW_1 + (size_t)4096 * 1024,
                 OW_END = OW_2 + (size_t)1024 * 4096;
static_assert(OW_END * 2 <= WBUF_BYTES, "weight buffer");

__device__ __forceinline__ unsigned f2bf(float f) { unsigned u = __builtin_bit_cast(unsigned, f); return (u + 0x7fffu + ((u >> 16) & 1u)) >> 16; }
__device__ __forceinline__ unsigned pk2(float lo, float hi) { return f2bf(lo) | (f2bf(hi) << 16); }
__device__ __forceinline__ float bf2f(unsigned short h) { return __builtin_bit_cast(float, (unsigned)h << 16); }
__device__ __forceinline__ float red4(float v) { v += __shfl_xor(v, 16); v += __shfl_xor(v, 32); return v; }
__device__ __forceinline__ float max4(float v) { v = fmaxf(v, __shfl_xor(v, 16)); v = fmaxf(v, __shfl_xor(v, 32)); return v; }
__device__ __forceinline__ float sumsq8(bf16x8 v) { float s = 0.f;
#pragma unroll
    for (int j = 0; j < 8; ++j) { const float f = bf2f((unsigned short)v[j]); s = fmaf(f, f, s); } return s; }
__device__ __forceinline__ u32x2 pack4(f32x4 v) { u32x2 w; w.x = pk2(v[0], v[1]); w.y = pk2(v[2], v[3]); return w; }
__device__ __forceinline__ f32x4 unpack4(u32x2 w) { f32x4 v; v[0] = __builtin_bit_cast(float, w.x << 16); v[1] = __builtin_bit_cast(float, w.x & 0xffff0000u);
    v[2] = __builtin_bit_cast(float, w.y << 16); v[3] = __builtin_bit_cast(float, w.y & 0xffff0000u); return v; }
#define MFMA16(a, b, c) __builtin_amdgcn_mfma_f32_16x16x32_bf16(a, b, c, 0, 0, 0)

struct Args { const float* in[N_IN]; float* out; unsigned char* ws; int ph_lo, ph_hi; };

struct Ctx {
    const float* const* in; float* out; unsigned char* ws;
    int tid, lane, wid, gw, ngw, fr, fq;
    float* scr;
    __device__ __forceinline__ bf16_t* wbuf(int layer) const { return (bf16_t*)(ws + WS_WBUF + (size_t)(layer & 1) * WBUF_BYTES); }
    template <class TT> __device__ __forceinline__ TT* p(size_t off) const { return (TT*)(ws + off); }
};

template <int MT, int NT, bool SS>
__device__ __forceinline__ void gemm_frag_loop(f32x4 (&acc)[MT][NT], const bf16_t* __restrict__ A, int lda, const bf16_t* __restrict__ Bt, int ldb, int K, int fr, int fq, float (&ss)[MT]) {
    const bf16_t* ap = A + (size_t)fr * lda + fq * 8;
    const bf16_t* bp = Bt + (size_t)fr * ldb + fq * 8;
#pragma unroll 2
    for (int k = 0; k < K; k += 32) {
        bf16x8 af[MT], bfr[NT];
#pragma unroll
        for (int m = 0; m < MT; ++m) af[m] = *(const bf16x8*)(ap + (size_t)m * 16 * lda + k);
#pragma unroll
        for (int n = 0; n < NT; ++n) bfr[n] = *(const bf16x8*)(bp + (size_t)n * 16 * ldb + k);
        if (SS) {
#pragma unroll
            for (int m = 0; m < MT; ++m) ss[m] += sumsq8(af[m]);
        }
#pragma unroll
        for (int m = 0; m < MT; ++m)
#pragma unroll
            for (int n = 0; n < NT; ++n) acc[m][n] = MFMA16(bfr[n], af[m], acc[m][n]);
    }
}
template <int MT, int NT> __device__ __forceinline__ void zero_acc(f32x4 (&acc)[MT][NT]) {
#pragma unroll
    for (int m = 0; m < MT; ++m)
#pragma unroll
        for (int n = 0; n < NT; ++n) acc[m][n] = (f32x4){0.f, 0.f, 0.f, 0.f};
}

__device__ __forceinline__ void wconv_item(const float* __restrict__ W, int N, const float* __restrict__ gain, bf16_t* dst, int dst_ld, int dst_koff, int kb, int nb, float* scr, int lane) {
    const int k0 = 64 * kb, n0 = 32 * nb;
#pragma unroll 8
    for (int i = 0; i < 32; ++i) { const int kk = 2 * i + (lane >> 5); float v = W[(size_t)(k0 + kk) * N + n0 + (lane & 31)]; if (gain) v *= gain[k0 + kk]; scr[kk * 33 + (lane & 31)] = v; }
    asm volatile("s_waitcnt lgkmcnt(0)" ::: "memory");
    const int c = lane & 7;
#pragma unroll
    for (int j = 0; j < 4; ++j) { const int n = (lane >> 3) + 8 * j; const float* s = scr + (8 * c) * 33 + n;
        u32x4 o; o.x = pk2(s[0 * 33], s[1 * 33]); o.y = pk2(s[2 * 33], s[3 * 33]); o.z = pk2(s[4 * 33], s[5 * 33]); o.w = pk2(s[6 * 33], s[7 * 33]);
        *(u32x4*)(dst + (size_t)(n0 + n) * dst_ld + dst_koff + k0 + 8 * c) = o; }
    asm volatile("s_waitcnt lgkmcnt(0)" ::: "memory");
}
struct WMat { const float* src; const float* gain; int K, N, dst_ld, dst_koff; size_t dst_off; };
__device__ __forceinline__ void convert_layer_weights(const Ctx& c, int l) {
    bf16_t* wb = c.wbuf(l);
    const float* const* in = c.in;
    constexpr int NM = 11;
    for (int mi = 0; mi < NM; ++mi) {
        WMat w;
        switch (mi) {
        case 0: w = {in[I_W_IN] + (size_t)l * 1024 * INCOLS, in[I_NORM_MIX] + l * 1024, 1024, INCOLS, 1024, 0, OW_IN}; break;
        case 1: w = {in[I_W_GLU] + (size_t)l * 512 * 512, nullptr, 512, 512, 512, 0, OW_GLU}; break;
        case 2: w = {in[I_W_UQ] + (size_t)l * 256 * 768, in[I_Q_NORM] + l * 256, 256, 768, 256, 0, OW_UQ}; break;
        case 3: w = {in[I_W_UKV] + (size_t)l * 128 * 1024, in[I_KV_NORM] + l * 128, 128, 1024, 128, 0, OW_UKV}; break;
        case 4: w = {in[I_W_OUT] + (size_t)l * 1024 * 1024, in[I_ON_SSM] + l * 512, 512, 1024, 1024, 0, OW_OUT}; break;
        case 5: w = {in[I_W_OUT] + (size_t)l * 1024 * 1024 + (size_t)512 * 1024, in[I_ON_MLA] + l * 512, 512, 1024, 1024, 512, OW_OUT}; break;
        case 6: w = {in[I_MEM_WQ] + (size_t)l * 1024 * 256, in[I_NMEM_Q] + l * 1024, 1024, 256, 1024, 0, OW_MQ}; break;
        case 7: w = {in[I_MEM_WKV] + (size_t)l * 1024 * 512, in[I_NMEM_KV] + l * 1024, 1024, 512, 1024, 0, OW_MKV}; break;
        case 8: w = {in[I_MEM_WO] + (size_t)l * 256 * 1024, nullptr, 256, 1024, 256, 0, OW_MO}; break;
        case 9: w = {in[I_W1] + (size_t)l * 1024 * 4096, in[I_NORM_MLP] + l * 1024, 1024, 4096, 1024, 0, OW_1}; break;
        default: w = {in[I_W2] + (size_t)l * 4096 * 1024, nullptr, 4096, 1024, 4096, 0, OW_2}; break;
        }
        const int nnb = w.N / 32, nit = (w.K / 64) * nnb;
        for (int it = c.gw; it < nit; it += c.ngw) wconv_item(w.src, w.N, w.gain, wb + w.dst_off, w.dst_ld, w.dst_koff, it / nnb, it % nnb, c.scr, c.lane);
    }
    { u32x4* z = (u32x4*)(wb + OW_IN + (size_t)INCOLS * 1024); const int n16 = (INPAD - INCOLS) * 1024 * 2 / 16;
      for (int i = c.gw * 64 + c.lane; i < n16; i += c.ngw * 64) z[i] = (u32x4){0u, 0u, 0u, 0u}; }
}

__device__ __forceinline__ void s5_tables(const Ctx& c, float* lds  ) {
    float* apr = lds;
    float* api = lds + 17 * 64;
    float* bbr = lds + 34 * 64;
    float* bbi = bbr + 64 * 16;
    float* cr = bbi + 64 * 16;
    float* ci = cr + 16 * 64;
    const float* const* in = c.in;
    for (int lg = blockIdx.x; lg < DEPTH * NGRP; lg += gridDim.x) {
        __syncthreads();
        const int tid = c.tid;
        if (tid < 64) {
            const int p = tid;
            const float lre = in[I_LAM_RE][lg * 64 + p], lim = in[I_LAM_IM][lg * 64 + p];
            const float step = expf(in[I_LOG_STEP][lg]);
            const float x = lre * step, th = lim * step;
            for (int tau = 0; tau <= 16; ++tau) { const float mg = expf(x * (float)tau); const float an = th * (float)tau; apr[tau * 64 + p] = mg * cosf(an); api[tau * 64 + p] = mg * sinf(an); }
            const float ex1 = expm1f(x), cs = cosf(th), sn = sinf(th), sh = sinf(0.5f * th);
            const float am1r = ex1 * cs - 2.f * sh * sh, am1i = (ex1 + 1.f) * sn;
            const float den = lre * lre + lim * lim;
            const float cfr = (am1r * lre + am1i * lim) / den, cfi = (am1i * lre - am1r * lim) / den;
            for (int h = 0; h < 16; ++h) { const float br = in[I_B_RE][(size_t)(lg * 64 + p) * 16 + h], bi = in[I_B_IM][(size_t)(lg * 64 + p) * 16 + h];
                bbr[p * 16 + h] = cfr * br - cfi * bi; bbi[p * 16 + h] = cfr * bi + cfi * br; }
            float* a16 = c.p<float>(WS_A16) + (size_t)(lg * 64 + p) * 2;
            const float m16 = expf(x * 16.f); a16[0] = m16 * cosf(th * 16.f); a16[1] = m16 * sinf(th * 16.f);
        }
        for (int i = tid; i < 16 * 64; i += blockDim.x) { cr[i] = in[I_C_RE][(size_t)lg * 1024 + i]; ci[i] = in[I_C_IM][(size_t)lg * 1024 + i]; }
        __syncthreads();
        bf16_t* kt = c.p<bf16_t>(WS_KTAB) + (size_t)lg * 4096;
        for (int e = tid; e < 4096; e += blockDim.x) {
            const int tau = e >> 8, h = (e >> 4) & 15, hp = e & 15; float s = 0.f;
            for (int p = 0; p < 64; ++p) { const float ar = apr[tau * 64 + p], ai = api[tau * 64 + p], c_r = cr[h * 64 + p], c_i = ci[h * 64 + p];
                const float zr = c_r * ar - c_i * ai, zi = c_r * ai + c_i * ar; s += zr * bbr[p * 16 + hp] - zi * bbi[p * 16 + hp]; }
            kt[e] = (bf16_t)f2bf(s);
        }
        bf16_t* we = c.p<bf16_t>(WS_WE) + (size_t)lg * 128 * 256;
        for (int e = tid; e < 128 * 256; e += blockDim.x) {
            const int i = e >> 8, k = e & 255, part = i >> 6, p = i & 63, s_ = k >> 4, hp = k & 15;
            const float ar = apr[(15 - s_) * 64 + p], ai = api[(15 - s_) * 64 + p], br = bbr[p * 16 + hp], bi = bbi[p * 16 + hp];
            we[e] = (bf16_t)f2bf(part == 0 ? (ar * br - ai * bi) : (ar * bi + ai * br));
        }
        bf16_t* wy = c.p<bf16_t>(WS_WY) + (size_t)lg * 256 * 128;
        for (int e = tid; e < 256 * 128; e += blockDim.x) {
            const int n = e >> 7, i = e & 127, t = n >> 4, h = n & 15, part = i >> 6, p = i & 63;
            const float ar = apr[(t + 1) * 64 + p], ai = api[(t + 1) * 64 + p], c_r = cr[h * 64 + p], c_i = ci[h * 64 + p];
            wy[e] = (bf16_t)f2bf(part == 0 ? (c_r * ar - c_i * ai) : -(c_r * ai + c_i * ar));
        }
    }
    __syncthreads();
}

__device__ __forceinline__ void rows_to_bf16(const Ctx& c, const float* src, bf16_t* dst, int nrows) {
    for (int r = c.gw; r < nrows; r += c.ngw) {
        const f32x4* xr = (const f32x4*)(src + (size_t)r * 1024) + c.lane; u32x2* o = (u32x2*)(dst + (size_t)r * 1024) + c.lane;
#pragma unroll
        for (int j = 0; j < 4; ++j) o[64 * j] = pack4(xr[64 * j]);
    }
}
__device__ __forceinline__ void phase_prologue(const Ctx& c) {
    rows_to_bf16(c, c.in[I_X], c.p<bf16_t>(WS_XB), T_);
    rows_to_bf16(c, c.in[I_MEM], c.p<bf16_t>(WS_MEMB), BATCH * NMEM);
    { const int* pos = (const int*)c.in[I_POS]; float* rc = c.p<float>(WS_ROPE_COS); float* rs = c.p<float>(WS_ROPE_SIN);
      for (int i = c.gw * 64 + c.lane; i < T_ * 16; i += c.ngw * 64) { const int t = i >> 4, j = i & 15;
          const float inv = exp2f(-(float)j * (13.287712379549449f / 16.f));
          const float ang = (float)pos[t] * inv; rc[i] = cosf(ang); rs[i] = sinf(ang); } }
    s5_tables(c, c.scr - c.wid * 64 * 33);
    convert_layer_weights(c, 0);
    convert_layer_weights(c, 1);
}

__device__ __forceinline__ void phase_inproj(const Ctx& c, int l) {
    const bf16_t* W = c.wbuf(l) + OW_IN; const bf16_t* XB = c.p<bf16_t>(WS_XB);
    bf16_t* U = c.p<bf16_t>(WS_U); bf16_t* CQ = c.p<bf16_t>(WS_CQ); bf16_t* CKV = c.p<bf16_t>(WS_CKV);
    constexpr int NCT = INPAD / 64, NWU = (T_ / 64) * NCT;
    for (int wu = c.gw; wu < NWU; wu += c.ngw) {
        const int rt = wu / NCT, ct = wu % NCT;
        f32x4 acc[4][4]; zero_acc(acc); float ss[4] = {0.f, 0.f, 0.f, 0.f};
        gemm_frag_loop<4, 4, true>(acc, XB + (size_t)rt * 64 * 1024, 1024, W + (size_t)ct * 64 * 1024, 1024, 1024, c.fr, c.fq, ss);
#pragma unroll
        for (int m = 0; m < 4; ++m) {
            const float rstd = 1.0f / sqrtf(red4(ss[m]) * (1.f / 1024.f) + EPS);
            const int row = rt * 64 + 16 * m + c.fr;
#pragma unroll
            for (int n = 0; n < 4; ++n) {
                const int col0 = ct * 64 + 16 * n; if (col0 >= INCOLS) continue;
                const int col = col0 + 4 * c.fq; const u32x2 w = pack4(acc[m][n] * rstd);
                if (col0 < 512) *(u32x2*)(U + (size_t)row * 512 + col) = w;
                else if (col0 < 768) *(u32x2*)(CQ + (size_t)row * 256 + (col - 512)) = w;
                else *(u32x2*)(CKV + (size_t)row * CKVP + (col - 768)) = w;
            }
        }
    }
}

__device__ __forceinline__ void phase_upproj(const Ctx& c, int l) {
    const float* rc = c.p<float>(WS_ROPE_COS); const float* rs = c.p<float>(WS_ROPE_SIN);
    const int fr = c.fr, fq = c.fq;
    {
        const bf16_t* CQ = c.p<bf16_t>(WS_CQ); const bf16_t* W = c.wbuf(l) + OW_UQ; bf16_t* Q = c.p<bf16_t>(WS_Q);
        const float* qg = c.in[I_Q_GAIN] + l * QKD; const float QS = LOG2E / sqrtf((float)QKD);
        constexpr int NWU = (T_ / 32) * MLAH;
        for (int wu = c.gw; wu < NWU; wu += c.ngw) {
            const int rt = wu / MLAH, h = wu % MLAH;
            f32x4 acc[2][6]; zero_acc(acc); float ss[2] = {0.f, 0.f};
            gemm_frag_loop<2, 6, true>(acc, CQ + (size_t)rt * 32 * 256, 256, W + (size_t)h * QKD * 256, 256, 256, fr, fq, ss);
#pragma unroll
            for (int m = 0; m < 2; ++m) {
                const int tok = rt * 32 + 16 * m + fr;
                const float rstd = 1.0f / sqrtf(red4(ss[m]) * (1.f / 256.f) + EPS);
                float hs = 0.f;
#pragma unroll
                for (int n = 0; n < 6; ++n) { acc[m][n] = acc[m][n] * rstd; hs += acc[m][n][0] * acc[m][n][0] + acc[m][n][1] * acc[m][n][1] + acc[m][n][2] * acc[m][n][2] + acc[m][n][3] * acc[m][n][3]; }
                const float rh = QS / sqrtf(red4(hs) * (1.f / 96.f) + EPS);
#pragma unroll
                for (int n = 0; n < 6; ++n) { const f32x4 g = *(const f32x4*)(qg + 16 * n + 4 * fq); acc[m][n] = acc[m][n] * g * rh; }
                const f32x4 cs = *(const f32x4*)(rc + (size_t)tok * 16 + 4 * fq), sn = *(const f32x4*)(rs + (size_t)tok * 16 + 4 * fq);
                const f32x4 x1 = acc[m][4], x2 = acc[m][5];
                acc[m][4] = x1 * cs - x2 * sn; acc[m][5] = x2 * cs + x1 * sn;
#pragma unroll
                for (int n = 0; n < 6; ++n) *(u32x2*)(Q + (size_t)tok * 768 + h * QKD + 16 * n + 4 * fq) = pack4(acc[m][n]);
            }
        }
    }
    {
        const bf16_t* CKV = c.p<bf16_t>(WS_CKV); const bf16_t* W = c.wbuf(l) + OW_UKV; bf16_t* K = c.p<bf16_t>(WS_K); bf16_t* VT = c.p<bf16_t>(WS_VT);
        const float* kg = c.in[I_K_GAIN] + l * QKD;
        constexpr int NWU = (T_ / 32) * MLAH;
        for (int wu = c.gw; wu < NWU; wu += c.ngw) {
            const int rt = wu / MLAH, h = wu % MLAH;
            f32x4 acc[2][8]; zero_acc(acc); float ss[2] = {0.f, 0.f};
            gemm_frag_loop<2, 8, true>(acc, CKV + (size_t)rt * 32 * CKVP, CKVP, W + (size_t)h * 128 * 128, 128, 128, fr, fq, ss);
#pragma unroll
            for (int m = 0; m < 2; ++m) {
                const int tok = rt * 32 + 16 * m + fr; const int b = tok / SEQ, s = tok % SEQ;
                const float rstd = 1.0f / sqrtf(red4(ss[m]) * (1.f / 128.f) + EPS);
                const f32x4 x1 = unpack4(*(const u32x2*)(CKV + (size_t)tok * CKVP + 128 + 4 * fq)), x2 = unpack4(*(const u32x2*)(CKV + (size_t)tok * CKVP + 144 + 4 * fq));
                float hs = x1[0] * x1[0] + x1[1] * x1[1] + x1[2] * x1[2] + x1[3] * x1[3] + x2[0] * x2[0] + x2[1] * x2[1] + x2[2] * x2[2] + x2[3] * x2[3];
#pragma unroll
                for (int n = 0; n < 8; ++n) acc[m][n] = acc[m][n] * rstd;
#pragma unroll
                for (int n = 0; n < 4; ++n) hs += acc[m][n][0] * acc[m][n][0] + acc[m][n][1] * acc[m][n][1] + acc[m][n][2] * acc[m][n][2] + acc[m][n][3] * acc[m][n][3];
                const float rk = 1.0f / sqrtf(red4(hs) * (1.f / 96.f) + EPS);
#pragma unroll
                for (int n = 0; n < 4; ++n) { const f32x4 g = *(const f32x4*)(kg + 16 * n + 4 * fq);
                    *(u32x2*)(K + (size_t)tok * 768 + h * QKD + 16 * n + 4 * fq) = pack4(acc[m][n] * g * rk); }
                const f32x4 g1 = *(const f32x4*)(kg + 64 + 4 * fq), g2 = *(const f32x4*)(kg + 80 + 4 * fq);
                const f32x4 a1 = x1 * g1 * rk, a2 = x2 * g2 * rk;
                const f32x4 cs = *(const f32x4*)(rc + (size_t)tok * 16 + 4 * fq), sn = *(const f32x4*)(rs + (size_t)tok * 16 + 4 * fq);
                *(u32x2*)(K + (size_t)tok * 768 + h * QKD + 64 + 4 * fq) = pack4(a1 * cs - a2 * sn);
                *(u32x2*)(K + (size_t)tok * 768 + h * QKD + 80 + 4 * fq) = pack4(a2 * cs + a1 * sn);
#pragma unroll
                for (int n = 4; n < 8; ++n)
#pragma unroll
                    for (int r = 0; r < 4; ++r) VT[((size_t)(b * MLAH + h) * VD + 16 * (n - 4) + 4 * fq + r) * SEQ + s] = (bf16_t)f2bf(acc[m][n][r]);
            }
        }
    }
    {
        const bf16_t* U = c.p<bf16_t>(WS_U); const bf16_t* WE = c.p<bf16_t>(WS_WE) + (size_t)l * NGRP * 128 * 256; float* E = c.p<float>(WS_E);
        constexpr int NWU = BATCH * NGRP * (NCH / 16);
        for (int wu = c.gw; wu < NWU; wu += c.ngw) {
            const int cgp = wu % (NCH / 16), g = (wu / (NCH / 16)) % NGRP, b = wu / ((NCH / 16) * NGRP);
            f32x4 acc[8];
#pragma unroll
            for (int i = 0; i < 8; ++i) acc[i] = (f32x4){0.f, 0.f, 0.f, 0.f};
            const bf16_t* ub = U + ((size_t)b * SEQ + (size_t)(cgp * 16 + fr) * CH + (fq >> 1)) * 512 + g * 16 + 8 * (fq & 1);
            const bf16_t* wb = WE + (size_t)g * 128 * 256 + (size_t)fr * 256 + 8 * fq;
#pragma unroll
            for (int ks = 0; ks < 8; ++ks) {
                const bf16x8 uf = *(const bf16x8*)(ub + (size_t)(2 * ks) * 512);
#pragma unroll
                for (int it = 0; it < 8; ++it) { const bf16x8 wf = *(const bf16x8*)(wb + (size_t)it * 16 * 256 + 32 * ks); acc[it] = MFMA16(wf, uf, acc[it]); }
            }
            float* eb = E + ((size_t)(b * NGRP + g) * NCH + cgp * 16 + fr) * 128 + 4 * fq;
#pragma unroll
            for (int it = 0; it < 8; ++it) *(f32x4*)(eb + 16 * it) = acc[it];
        }
    }
    {
        const bf16_t* MB = c.p<bf16_t>(WS_MEMB); const bf16_t* W = c.wbuf(l) + OW_MKV; bf16_t* KM = c.p<bf16_t>(WS_KMEM); bf16_t* VMT = c.p<bf16_t>(WS_VMEMT);
        const float* kg = c.in[I_MEM_KG] + l * MEMHD;
        constexpr int NWU = (BATCH * NMEM / 32) * MEMH;
        for (int wu = c.gw; wu < NWU; wu += c.ngw) {
            const int rt = wu / MEMH, h = wu % MEMH;
            f32x4 acc[2][8]; zero_acc(acc); float ss[2] = {0.f, 0.f};
            gemm_frag_loop<2, 8, true>(acc, MB + (size_t)rt * 32 * 1024, 1024, W + (size_t)h * 128 * 1024, 1024, 1024, fr, fq, ss);
#pragma unroll
            for (int m = 0; m < 2; ++m) {
                const int row = rt * 32 + 16 * m + fr; const int b = row / NMEM, key = row % NMEM;
                const float rstd = 1.0f / sqrtf(red4(ss[m]) * (1.f / 1024.f) + EPS);
                float hs = 0.f;
#pragma unroll
                for (int n = 0; n < 8; ++n) acc[m][n] = acc[m][n] * rstd;
#pragma unroll
                for (int n = 0; n < 4; ++n) hs += acc[m][n][0] * acc[m][n][0] + acc[m][n][1] * acc[m][n][1] + acc[m][n][2] * acc[m][n][2] + acc[m][n][3] * acc[m][n][3];
                const float rk = 1.0f / sqrtf(red4(hs) * (1.f / 64.f) + EPS);
#pragma unroll
                for (int n = 0; n < 4; ++n) { const f32x4 g = *(const f32x4*)(kg + 16 * n + 4 * fq);
                    *(u32x2*)(KM + ((size_t)(b * MEMH + h) * NMEM + key) * MEMHD + 16 * n + 4 * fq) = pack4(acc[m][n] * g * rk); }
#pragma unroll
                for (int n = 4; n < 8; ++n)
#pragma unroll
                    for (int r = 0; r < 4; ++r) VMT[((size_t)(b * MEMH + h) * MEMHD + 16 * (n - 4) + 4 * fq + r) * NMEM + key] = (bf16_t)f2bf(acc[m][n][r]);
            }
        }
    }
}

template <int KS, bool CAUSAL>
__device__ __forceinline__ void attn_wave(const bf16_t* qp, int q_ld, const bf16_t* kp, int k_ld, const bf16_t* vp, int v_ld, bf16_t* op, int o_ld, int nkb, int qpos0, int fr, int fq) {
    bf16x8 qf[KS];
#pragma unroll
    for (int ks = 0; ks < KS; ++ks) qf[ks] = *(const bf16x8*)(qp + (size_t)fr * q_ld + 32 * ks + 8 * fq);
    f32x4 o[4];
#pragma unroll
    for (int d = 0; d < 4; ++d) o[d] = (f32x4){0.f, 0.f, 0.f, 0.f};
    float mrun = -INFINITY, lsum = 0.f;
    const int qpos = qpos0 + fr;
    for (int kb = 0; kb < nkb; ++kb) {
        const int key0 = kb * 32;
        f32x4 sa = (f32x4){0.f, 0.f, 0.f, 0.f}, sb = (f32x4){0.f, 0.f, 0.f, 0.f};
#pragma unroll
        for (int ks = 0; ks < KS; ++ks) {
            const bf16x8 ka = *(const bf16x8*)(kp + (size_t)(key0 + fr) * k_ld + 32 * ks + 8 * fq);
            const bf16x8 kc = *(const bf16x8*)(kp + (size_t)(key0 + 16 + fr) * k_ld + 32 * ks + 8 * fq);
            sa = MFMA16(ka, qf[ks], sa); sb = MFMA16(kc, qf[ks], sb);
        }
        if (CAUSAL) {
#pragma unroll
            for (int r = 0; r < 4; ++r) { const int ka = key0 + 4 * fq + r; if (ka > qpos) sa[r] = -INFINITY; if (ka + 16 > qpos) sb[r] = -INFINITY; }
        }
        float mx = fmaxf(fmaxf(fmaxf(sa[0], sa[1]), fmaxf(sa[2], sa[3])), fmaxf(fmaxf(sb[0], sb[1]), fmaxf(sb[2], sb[3])));
        mx = max4(mx);
        const float mn = fmaxf(mrun, mx); const float alpha = exp2f(mrun - mn); mrun = mn;
        float ps = 0.f;
#pragma unroll
        for (int r = 0; r < 4; ++r) { sa[r] = exp2f(sa[r] - mn); sb[r] = exp2f(sb[r] - mn); ps += sa[r] + sb[r]; }
        lsum = lsum * alpha + ps;
#pragma unroll
        for (int d = 0; d < 4; ++d) o[d] = o[d] * alpha;
        const u32x2 pa = pack4(sa), pb = pack4(sb);
        const bf16x8 pf = __builtin_bit_cast(bf16x8, (u32x4){pa.x, pa.y, pb.x, pb.y});
#pragma unroll
        for (int d = 0; d < 4; ++d) {
            const bf16_t* vr = vp + (size_t)(16 * d + fr) * v_ld + key0 + 4 * fq;
            const u32x2 v0 = *(const u32x2*)vr, v1 = *(const u32x2*)(vr + 16);
            const bf16x8 vf = __builtin_bit_cast(bf16x8, (u32x4){v0.x, v0.y, v1.x, v1.y});
            o[d] = MFMA16(vf, pf, o[d]);
        }
    }
    const float inv = 1.0f / red4(lsum);
#pragma unroll
    for (int d = 0; d < 4; ++d) *(u32x2*)(op + (size_t)fr * o_ld + 16 * d + 4 * fq) = pack4(o[d] * inv);
}

__device__ __forceinline__ void phase_attn(const Ctx& c, int l) {
    {
        float* E = c.p<float>(WS_E); const float* A16 = c.p<float>(WS_A16) + (size_t)l * NGRP * 64 * 2;
        for (int i = blockIdx.x * blockDim.x + c.tid; i < BATCH * NGRP * 64; i += gridDim.x * blockDim.x) {
            const int p = i & 63, bg = i >> 6, g = bg % NGRP;
            const float ar = A16[(g * 64 + p) * 2], ai = A16[(g * 64 + p) * 2 + 1];
            float hr = 0.f, hi = 0.f; float* e = E + (size_t)bg * NCH * 128 + p;
            for (int ch = 0; ch < NCH; ++ch) { const float er = e[0], ei = e[64]; e[0] = hr; e[64] = hi;
                const float nr = ar * hr - ai * hi + er, ni = ar * hi + ai * hr + ei; hr = nr; hi = ni; e += 128; }
        }
    }
    const bf16_t* Q = c.p<bf16_t>(WS_Q); const bf16_t* K = c.p<bf16_t>(WS_K); const bf16_t* VT = c.p<bf16_t>(WS_VT); bf16_t* Y = c.p<bf16_t>(WS_YMLA);
    for (int u = blockIdx.x; u < 1024; u += gridDim.x) {
        const int i = u >> 8, blk = u & 255, pair = blk >> 3, s = blk & 7;
        const int qt = (i == 0) ? s : (i == 1) ? 15 - s : (i == 2) ? 16 + s : 31 - s;
        const int b = pair >> 3, h = pair & 7;
        const int r0 = qt * 128 + c.wid * 16; const size_t tok0 = (size_t)b * SEQ;
        attn_wave<3, true>(Q + (tok0 + r0) * 768 + h * QKD, 768, K + tok0 * 768 + h * QKD, 768, VT + (size_t)(b * MLAH + h) * VD * SEQ, SEQ,
                           Y + (tok0 + r0) * 512 + h * VD, 512, (r0 + 16 + 31) / 32, r0, c.fr, c.fq);
    }
}

__device__ __forceinline__ float gelu_tanh(float x) { const float z = 0.7978845608028654f * (x + 0.044715f * x * x * x); const float e = __expf(2.f * z); const float th = 1.f - 2.f / (e + 1.f); return 0.5f * x * (1.f + th); }
__device__ __forceinline__ void phase_s5out(const Ctx& c, int l) {
    const int fr = c.fr, fq = c.fq;
    const bf16_t* U = c.p<bf16_t>(WS_U); const float* H = c.p<float>(WS_E); bf16_t* YG = c.p<bf16_t>(WS_YG);
    const bf16_t* KT = c.p<bf16_t>(WS_KTAB) + (size_t)l * NGRP * 4096; const bf16_t* WY = c.p<bf16_t>(WS_WY) + (size_t)l * NGRP * 256 * 128;
    const float* Dv = c.in[I_SSM_D] + l * SSMW;
    constexpr int NWU = BATCH * NGRP * (NCH / 16);
    for (int wu = c.gw; wu < NWU; wu += c.ngw) {
        const int cgp = wu % (NCH / 16), g = (wu / (NCH / 16)) % NGRP, b = wu / ((NCH / 16) * NGRP);
        const size_t tokc = (size_t)b * SEQ + (size_t)(cgp * 16 + fr) * CH;
        bf16x8 uf[8];
#pragma unroll
        for (int sp = 0; sp < 8; ++sp) uf[sp] = *(const bf16x8*)(U + (tokc + 2 * sp + (fq >> 1)) * 512 + g * 16 + 8 * (fq & 1));
        bf16x8 hf[4];
        { const float* hb = H + ((size_t)(b * NGRP + g) * NCH + cgp * 16 + fr) * 128 + 8 * fq;
#pragma unroll
          for (int ks = 0; ks < 4; ++ks) { const f32x4 a = *(const f32x4*)(hb + 32 * ks), bq = *(const f32x4*)(hb + 32 * ks + 4);
              const u32x2 p0 = pack4(a), p1 = pack4(bq); hf[ks] = __builtin_bit_cast(bf16x8, (u32x4){p0.x, p0.y, p1.x, p1.y}); } }
        const bf16_t* kt = KT + (size_t)g * 4096 + fr * 16 + 8 * (fq & 1);
        const bf16_t* wy = WY + (size_t)g * 256 * 128 + (size_t)fr * 128 + 8 * fq;
        const f32x4 dv = *(const f32x4*)(Dv + g * 16 + 4 * fq);
#pragma unroll
        for (int t = 0; t < 16; ++t) {
            f32x4 acc = (f32x4){0.f, 0.f, 0.f, 0.f};
#pragma unroll
            for (int sp = 0; sp <= (t >> 1); ++sp) {
                const int tau = t - 2 * sp - (fq >> 1);
                bf16x8 kf = (bf16x8){0, 0, 0, 0, 0, 0, 0, 0};
                if (tau >= 0) kf = *(const bf16x8*)(kt + tau * 256);
                acc = MFMA16(kf, uf[sp], acc);
            }
#pragma unroll
            for (int ks = 0; ks < 4; ++ks) { const bf16x8 wf = *(const bf16x8*)(wy + (size_t)t * 16 * 128 + 32 * ks); acc = MFMA16(wf, hf[ks], acc); }
            const f32x4 uv = unpack4(*(const u32x2*)(U + (tokc + t) * 512 + g * 16 + 4 * fq));
            f32x4 y = acc + dv * uv;
#pragma unroll
            for (int r = 0; r < 4; ++r) y[r] = gelu_tanh(y[r]);
            *(u32x2*)(YG + (tokc + t) * 512 + g * 16 + 4 * fq) = pack4(y);
        }
    }
}

__device__ __forceinline__ void phase_glu(const Ctx& c, int l) {
    const bf16_t* YG = c.p<bf16_t>(WS_YG); const bf16_t* W = c.wbuf(l) + OW_GLU; bf16_t* YS = c.p<bf16_t>(WS_YSSM); const float* bg = c.in[I_B_GLU] + l * SSMW;
    constexpr int NCT = SSMW / 64, NWU = (T_ / 64) * NCT;
    for (int wu = c.gw; wu < NWU; wu += c.ngw) {
        const int rt = wu / NCT, ct = wu % NCT;
        f32x4 acc[4][4]; zero_acc(acc); float ss[4];
        gemm_frag_loop<4, 4, false>(acc, YG + (size_t)rt * 64 * 512, 512, W + (size_t)ct * 64 * 512, 512, 512, c.fr, c.fq, ss);
#pragma unroll
        for (int m = 0; m < 4; ++m)
#pragma unroll
            for (int n = 0; n < 4; ++n) {
                const int row = rt * 64 + 16 * m + c.fr, col = ct * 64 + 16 * n + 4 * c.fq;
                const f32x4 z = acc[m][n] + *(const f32x4*)(bg + col); const f32x4 y = unpack4(*(const u32x2*)(YG + (size_t)row * 512 + col));
                f32x4 o;
#pragma unroll
                for (int r = 0; r < 4; ++r) o[r] = y[r] / (1.f + __expf(-z[r]));
                *(u32x2*)(YS + (size_t)row * 512 + col) = pack4(o);
            }
    }
}

__device__ __forceinline__ void resid_store(const float* xold, float* out, bf16_t* XB, int row, int col, f32x4 v) {
    const f32x4 xo = *(const f32x4*)(xold + (size_t)row * DM + col); const f32x4 xn = xo + v;
    *(f32x4*)(out + (size_t)row * DM + col) = xn; *(u32x2*)(XB + (size_t)row * DM + col) = pack4(xn);
}

__device__ __forceinline__ void phase_wout(const Ctx& c, int l) {
    const bf16_t* YS = c.p<bf16_t>(WS_YSSM); const bf16_t* YM = c.p<bf16_t>(WS_YMLA); const bf16_t* W = c.wbuf(l) + OW_OUT; bf16_t* XB = c.p<bf16_t>(WS_XB);
    const float* xold = (l == 0) ? c.in[I_X] : c.out;
    constexpr int NCT = DM / 64, NWU = (T_ / 32) * NCT;
    for (int wu = c.gw; wu < NWU; wu += c.ngw) {
        const int rt = wu / NCT, ct = wu % NCT;
        f32x4 a1[2][4], a2[2][4]; zero_acc(a1); zero_acc(a2); float s1[2] = {0.f, 0.f}, s2[2] = {0.f, 0.f};
        gemm_frag_loop<2, 4, true>(a1, YS + (size_t)rt * 32 * 512, 512, W + (size_t)ct * 64 * 1024, 1024, 512, c.fr, c.fq, s1);
        gemm_frag_loop<2, 4, true>(a2, YM + (size_t)rt * 32 * 512, 512, W + (size_t)ct * 64 * 1024 + 512, 1024, 512, c.fr, c.fq, s2);
#pragma unroll
        for (int m = 0; m < 2; ++m) {
            const float r1 = 1.0f / sqrtf(red4(s1[m]) * (1.f / 512.f) + EPS), r2 = 1.0f / sqrtf(red4(s2[m]) * (1.f / 512.f) + EPS);
            const int row = rt * 32 + 16 * m + c.fr;
#pragma unroll
            for (int n = 0; n < 4; ++n) resid_store(xold, c.out, XB, row, ct * 64 + 16 * n + 4 * c.fq, a1[m][n] * r1 + a2[m][n] * r2);
        }
    }
}

__device__ __forceinline__ void phase_memq(const Ctx& c, int l) {
    const bf16_t* XB = c.p<bf16_t>(WS_XB); const bf16_t* W = c.wbuf(l) + OW_MQ; bf16_t* MQ = c.p<bf16_t>(WS_MQ); const float* qg = c.in[I_MEM_QG] + l * MEMHD;
    const float QS = LOG2E / 8.f;
    constexpr int NWU = (T_ / 32) * MEMH;
    for (int wu = c.gw; wu < NWU; wu += c.ngw) {
        const int rt = wu / MEMH, h = wu % MEMH;
        f32x4 acc[2][4]; zero_acc(acc); float ss[2] = {0.f, 0.f};
        gemm_frag_loop<2, 4, true>(acc, XB + (size_t)rt * 32 * 1024, 1024, W + (size_t)h * 64 * 1024, 1024, 1024, c.fr, c.fq, ss);
#pragma unroll
        for (int m = 0; m < 2; ++m) {
            const int row = rt * 32 + 16 * m + c.fr;
            const float rstd = 1.0f / sqrtf(red4(ss[m]) * (1.f / 1024.f) + EPS);
            float hs = 0.f;
#pragma unroll
            for (int n = 0; n < 4; ++n) { acc[m][n] = acc[m][n] * rstd; hs += acc[m][n][0] * acc[m][n][0] + acc[m][n][1] * acc[m][n][1] + acc[m][n][2] * acc[m][n][2] + acc[m][n][3] * acc[m][n][3]; }
            const float rh = QS / sqrtf(red4(hs) * (1.f / 64.f) + EPS);
#pragma unroll
            for (int n = 0; n < 4; ++n) { const f32x4 g = *(const f32x4*)(qg + 16 * n + 4 * c.fq); *(u32x2*)(MQ + (size_t)row * 256 + h * 64 + 16 * n + 4 * c.fq) = pack4(acc[m][n] * g * rh); }
        }
    }
}

__device__ __forceinline__ void phase_memattn(const Ctx& c) {
    const bf16_t* MQ = c.p<bf16_t>(WS_MQ); const bf16_t* KM = c.p<bf16_t>(WS_KMEM); const bf16_t* VMT = c.p<bf16_t>(WS_VMEMT); bf16_t* O = c.p<bf16_t>(WS_O);
    constexpr int NU = BATCH * MEMH * (SEQ / 128);
    for (int u = blockIdx.x; u < NU; u += gridDim.x) {
        const int qt = u % (SEQ / 128), h = (u / (SEQ / 128)) % MEMH, b = u / ((SEQ / 128) * MEMH);
        const size_t tok = (size_t)b * SEQ + qt * 128 + c.wid * 16;
        attn_wave<2, false>(MQ + tok * 256 + h * 64, 256, KM + (size_t)(b * MEMH + h) * NMEM * MEMHD, MEMHD, VMT + (size_t)(b * MEMH + h) * MEMHD * NMEM, NMEM,
                            O + tok * 256 + h * 64, 256, NMEM / 32, 0, c.fr, c.fq);
    }
}

__device__ __forceinline__ void phase_gemm_resid(const Ctx& c, const bf16_t* A, int lda, const bf16_t* W, int K) {
    bf16_t* XB = c.p<bf16_t>(WS_XB);
    constexpr int NCT = DM / 64, NWU = (T_ / 64) * NCT;
    for (int wu = c.gw; wu < NWU; wu += c.ngw) {
        const int rt = wu / NCT, ct = wu % NCT;
        f32x4 acc[4][4]; zero_acc(acc); float ss[4];
        gemm_frag_loop<4, 4, false>(acc, A + (size_t)rt * 64 * lda, lda, W + (size_t)ct * 64 * K, K, K, c.fr, c.fq, ss);
#pragma unroll
        for (int m = 0; m < 4; ++m)
#pragma unroll
            for (int n = 0; n < 4; ++n) resid_store(c.out, c.out, XB, rt * 64 + 16 * m + c.fr, ct * 64 + 16 * n + 4 * c.fq, acc[m][n]);
    }
}

__device__ __forceinline__ void phase_mlp_up(const Ctx& c, int l) {
    const bf16_t* XB = c.p<bf16_t>(WS_XB); const bf16_t* W = c.wbuf(l) + OW_1; bf16_t* HB = c.p<bf16_t>(WS_HB);
    constexpr int NCT = DFF / 64, NWU = (T_ / 64) * NCT;
    for (int wu = c.gw; wu < NWU; wu += c.ngw) {
        const int rt = wu / NCT, ct = wu % NCT;
        f32x4 acc[4][4]; zero_acc(acc); float ss[4] = {0.f, 0.f, 0.f, 0.f};
        gemm_frag_loop<4, 4, true>(acc, XB + (size_t)rt * 64 * 1024, 1024, W + (size_t)ct * 64 * 1024, 1024, 1024, c.fr, c.fq, ss);
#pragma unroll
        for (int m = 0; m < 4; ++m) {
            const float rstd = 1.0f / sqrtf(red4(ss[m]) * (1.f / 1024.f) + EPS);
#pragma unroll
            for (int n = 0; n < 4; ++n) { f32x4 v = acc[m][n] * rstd;
#pragma unroll
                for (int r = 0; r < 4; ++r) { const float t = fmaxf(v[r], 0.f); v[r] = t * t; }
                *(u32x2*)(HB + (size_t)(rt * 64 + 16 * m + c.fr) * DFF + ct * 64 + 16 * n + 4 * c.fq) = pack4(v); }
        }
    }
}

constexpr int PH_PER_LAYER = 11, N_PHASES = 1 + DEPTH * PH_PER_LAYER;
__global__ void __launch_bounds__(512) hymba_fwd(Args a) {
    __shared__ float lds_scr[8 * 64 * 33];
    Ctx c; c.in = a.in; c.out = a.out; c.ws = a.ws;
    c.tid = threadIdx.x; c.lane = c.tid & 63; c.wid = __builtin_amdgcn_readfirstlane(c.tid >> 6);
    c.gw = blockIdx.x * 8 + c.wid; c.ngw = gridDim.x * 8; c.fr = c.lane & 15; c.fq = c.lane >> 4;
    c.scr = lds_scr + c.wid * 64 * 33;
    for (int ph = a.ph_lo; ph < a.ph_hi; ++ph) {
        { int t_ = threadIdx.x; asm volatile("" : "+v"(t_));
          c.tid = t_; c.lane = t_ & 63; c.fr = c.lane & 15; c.fq = c.lane >> 4; }
        if (ph == 0) phase_prologue(c);
        else {
            const int l = (ph - 1) / PH_PER_LAYER, sub = (ph - 1) % PH_PER_LAYER;
            switch (sub) {
            case 0: phase_inproj(c, l); if (l >= 1 && l + 1 < DEPTH) convert_layer_weights(c, l + 1); break;
            case 1: phase_upproj(c, l); break;
            case 2: phase_attn(c, l); break;
            case 3: phase_s5out(c, l); break;
            case 4: phase_glu(c, l); break;
            case 5: phase_wout(c, l); break;
            case 6: phase_memq(c, l); break;
            case 7: phase_memattn(c); break;
            case 8: phase_gemm_resid(c, c.p<bf16_t>(WS_O), 256, c.wbuf(l) + OW_MO, 256); break;
            case 9: phase_mlp_up(c, l); break;
            default: phase_gemm_resid(c, c.p<bf16_t>(WS_HB), DFF, c.wbuf(l) + OW_2, DFF); break;
            }
        }
#if !MK_PER_PHASE
        if (ph + 1 < a.ph_hi) cg::this_grid().sync();
#endif
    }
}

extern "C" void kernel_launch(void* const* d_in, const int* in_sizes, int n_in, void* d_out, int out_size, void* d_ws, size_t ws_size, hipStream_t stream) {
    static int grid = 0;
    if (grid == 0) {
        if (n_in != N_IN || out_size != T_ * DM || ws_size < WS_END) { fprintf(stderr, "kernel_launch: unexpected shapes n_in %d out %d ws %zu\n", n_in, out_size, ws_size); grid = -1; return; }
        int dev = 0, cus = 0, per_cu = 0;
        hipGetDevice(&dev); hipDeviceGetAttribute(&cus, hipDeviceAttributeMultiprocessorCount, dev);
        hipOccupancyMaxActiveBlocksPerMultiprocessor(&per_cu, (const void*)hymba_fwd, 512, 0);
        if (per_cu < 1) { fprintf(stderr, "kernel_launch: occupancy query returned %d\n", per_cu); grid = -1; return; }
        if (per_cu > 2) per_cu = 2;
        grid = cus * per_cu;
        fprintf(stderr, "kernel_launch: grid %d (%d CUs x %d), ws %zu\n", grid, cus, per_cu, ws_size);
    }
    if (grid < 0) return;
    Args a{};
    for (int i = 0; i < N_IN; ++i) a.in[i] = (const float*)d_in[i];
    a.out = (float*)d_out; a.ws = (unsigned char*)d_ws;
#if MK_PER_PHASE
    for (int ph = 0; ph < N_PHASES; ++ph) { a.ph_lo = ph; a.ph_hi = ph + 1; hipLaunchKernelGGL(hymba_fwd, dim3(grid), dim3(512), 0, stream, a); }
#else
    a.ph_lo = 0; a.ph_hi = N_PHASES;
    void* params[] = {&a};
    hipError_t e = hipLaunchCooperativeKernel((const void*)hymba_fwd, dim3(grid), dim3(512), params, 0, stream);
    if (e != hipSuccess) fprintf(stderr, "kernel_launch: cooperative launch failed: %s (grid %d)\n", hipGetErrorString(e), grid);
#endif
}
```

```cpp
#include <hip/hip_runtime.h>
#include <hip/hip_cooperative_groups.h>
#include <cstdio>
#include <cstdint>
namespace cg = cooperative_groups;

#ifndef PROBE_MASK
#define PROBE_MASK 0
#endif
#ifndef MK_PER_PHASE
#define MK_PER_PHASE 0
#endif

typedef unsigned short bf16_t;
typedef short bf16x8 __attribute__((ext_vector_type(8)));
typedef short bf16x4 __attribute__((ext_vector_type(4)));
typedef float f32x4 __attribute__((ext_vector_type(4)));
typedef unsigned u32x2 __attribute__((ext_vector_type(2)));
typedef unsigned u32x4 __attribute__((ext_vector_type(4)));

constexpr int DEPTH = 4, BATCH = 4, SEQ = 4096, DM = 1024, T_ = BATCH * SEQ;
constexpr int NMEM = 256, MEMH = 4, MEMHD = 64, MEMW = 256;
constexpr int SSMW = 512, NGRP = 32, SGRP = 16, SST = 64;
constexpr int MLAH = 8, QKN = 64, QKR = 32, QKD = 96, VD = 64, QLORA = 256, KVLORA = 128;
constexpr int DFF = 4096, INCOLS = 928, INPAD = 1024;
constexpr float EPS = 1e-6f;
constexpr float LOG2E = 1.4426950408889634f;
constexpr int CH = 16;
constexpr int NCH = SEQ / CH;

enum { I_X = 0, I_MEM, I_POS, I_NORM_MIX, I_W_IN, I_LAM_RE, I_LAM_IM, I_LOG_STEP, I_B_RE, I_B_IM, I_C_RE, I_C_IM, I_SSM_D, I_W_GLU, I_B_GLU,
       I_Q_NORM, I_W_UQ, I_KV_NORM, I_W_UKV, I_Q_GAIN, I_K_GAIN, I_ON_SSM, I_ON_MLA, I_W_OUT, I_NMEM_Q, I_NMEM_KV, I_MEM_WQ, I_MEM_WKV,
       I_MEM_QG, I_MEM_KG, I_MEM_WO, I_NORM_MLP, I_W1, I_W2, N_IN };

constexpr size_t MiB = 1u << 20;
constexpr size_t WS_ROPE_COS = 1 * MiB, WS_ROPE_SIN = 2 * MiB;
constexpr size_t WS_MEMB = 3 * MiB;
constexpr size_t WS_KMEM = 5 * MiB;
constexpr size_t WS_VMEMT = 5 * MiB + 512 * 1024;
constexpr size_t WS_KTAB = 6 * MiB;
constexpr size_t WS_WE = 7 * MiB;
constexpr size_t WS_WY = 15 * MiB;
constexpr size_t WS_A16 = 23 * MiB;
constexpr size_t WS_SSP = 23 * MiB + 64 * 1024;
constexpr size_t WS_SSYS = 24 * MiB + 512 * 1024;
constexpr size_t WS_SSYM = 25 * MiB;
constexpr size_t WS_WBUF = 26 * MiB;
constexpr size_t WBUF_BYTES = 24 * MiB;
constexpr size_t WS_XB = 74 * MiB;
constexpr size_t WS_R = 106 * MiB;
constexpr size_t WS_U = WS_R, WS_CQ = WS_R + 16 * MiB, WS_CKV = WS_R + 24 * MiB;
constexpr size_t WS_Q = WS_R + 30 * MiB, WS_K = WS_R + 54 * MiB, WS_VT = WS_R + 78 * MiB;
constexpr size_t WS_E = WS_R + 94 * MiB;
constexpr size_t WS_YCAT = WS_R + 110 * MiB;
constexpr size_t WS_YG = WS_Q;
constexpr size_t WS_MQ = WS_R, WS_O = WS_R + 8 * MiB;
constexpr size_t WS_HB = WS_R;
constexpr size_t WS_END = WS_R + 142 * MiB;
constexpr int CKVP = 160;

constexpr size_t OW_IN = 0, OW_GLU = OW_IN + (size_t)INPAD * 1024, OW_UQ = OW_GLU + 512 * 512, OW_UKV = OW_UQ + 768 * 256, OW_OUT = OW_UKV + 1024 * 128,
                 OW_MQ = OW_OUT + 1024 * 1024, OW_MKV = OW_MQ + 256 * 1024, OW_MO = OW_MKV + 512 * 1024, OW_1 = OW_MO + 1024 * 256, OW_2 = OW_1 + (size_t)4096 * 1024,
                 OW_END = OW_2 + (size_t)1024 * 4096;
static_assert(OW_END * 2 <= WBUF_BYTES, "weight buffer");

__device__ __forceinline__ unsigned f2bf(float f) { unsigned u = __builtin_bit_cast(unsigned, f); return (u + 0x7fffu + ((u >> 16) & 1u)) >> 16; }
__device__ __forceinline__ unsigned pk2(float lo, float hi) { return f2bf(lo) | (f2bf(hi) << 16); }
__device__ __forceinline__ float bf2f(unsigned short h) { return __builtin_bit_cast(float, (unsigned)h << 16); }
__device__ __forceinline__ float red4(float v) { v += __shfl_xor(v, 16); v += __shfl_xor(v, 32); return v; }
__device__ __forceinline__ float max4(float v) { v = fmaxf(v, __shfl_xor(v, 16)); v = fmaxf(v, __shfl_xor(v, 32)); return v; }
__device__ __forceinline__ float sumsq8(bf16x8 v) { float s = 0.f;
#pragma unroll
    for (int j = 0; j < 8; ++j) { const float f = bf2f((unsigned short)v[j]); s = fmaf(f, f, s); } return s; }
__device__ __forceinline__ u32x2 pack4(f32x4 v) { u32x2 w; w.x = pk2(v[0], v[1]); w.y = pk2(v[2], v[3]); return w; }
__device__ __forceinline__ f32x4 unpack4(u32x2 w) { f32x4 v; v[0] = __builtin_bit_cast(float, w.x << 16); v[1] = __builtin_bit_cast(float, w.x & 0xffff0000u);
    v[2] = __builtin_bit_cast(float, w.y << 16); v[3] = __builtin_bit_cast(float, w.y & 0xffff0000u); return v; }
#define MFMA16(a, b, c) __builtin_amdgcn_mfma_f32_16x16x32_bf16(a, b, c, 0, 0, 0)
#define PG8_LAS __attribute__((address_space(3)))

struct Args { const float* in[N_IN]; float* out; unsigned char* ws; int ph_lo, ph_hi; };

struct Ctx {
    const float* const* in; float* out; unsigned char* ws;
    int tid, lane, wid, gw, ngw, fr, fq;
    float* scr;
    PG8_LAS unsigned char* lds;
    __device__ __forceinline__ bf16_t* wbuf(int layer) const { return (bf16_t*)(ws + WS_WBUF + (size_t)(layer & 1) * WBUF_BYTES); }
    template <class TT> __device__ __forceinline__ TT* p(size_t off) const { return (TT*)(ws + off); }
};

template <int MT, int NT, bool SS>
__device__ __forceinline__ void gemm_frag_loop(f32x4 (&acc)[MT][NT], const bf16_t* __restrict__ A, int lda, const bf16_t* __restrict__ Bt, int ldb, int K, int fr, int fq, float (&ss)[MT]) {
    const bf16_t* ap = A + (size_t)fr * lda + fq * 8;
    const bf16_t* bp = Bt + (size_t)fr * ldb + fq * 8;
#pragma unroll 2
    for (int k = 0; k < K; k += 32) {
        bf16x8 af[MT], bfr[NT];
#pragma unroll
        for (int m = 0; m < MT; ++m) af[m] = *(const bf16x8*)(ap + (size_t)m * 16 * lda + k);
#pragma unroll
        for (int n = 0; n < NT; ++n) bfr[n] = *(const bf16x8*)(bp + (size_t)n * 16 * ldb + k);
        if (SS) {
#pragma unroll
            for (int m = 0; m < MT; ++m) ss[m] += sumsq8(af[m]);
        }
#pragma unroll
        for (int m = 0; m < MT; ++m)
#pragma unroll
            for (int n = 0; n < NT; ++n) acc[m][n] = MFMA16(bfr[n], af[m], acc[m][n]);
    }
}
template <int MT, int NT> __device__ __forceinline__ void zero_acc(f32x4 (&acc)[MT][NT]) {
#pragma unroll
    for (int m = 0; m < MT; ++m)
#pragma unroll
        for (int n = 0; n < NT; ++n) acc[m][n] = (f32x4){0.f, 0.f, 0.f, 0.f};
}

__device__ __forceinline__ void wconv_item(const float* __restrict__ W, int N, const float* __restrict__ gain, bf16_t* dst, int dst_ld, int dst_koff, int kb, int nb, float* scr, int lane) {
    const int k0 = 64 * kb, n0 = 32 * nb;
#pragma unroll 8
    for (int i = 0; i < 32; ++i) { const int kk = 2 * i + (lane >> 5); float v = W[(size_t)(k0 + kk) * N + n0 + (lane & 31)]; if (gain) v *= gain[k0 + kk]; scr[kk * 33 + (lane & 31)] = v; }
    asm volatile("s_waitcnt lgkmcnt(0)" ::: "memory");
    const int c = lane & 7;
#pragma unroll
    for (int j = 0; j < 4; ++j) { const int n = (lane >> 3) + 8 * j; const float* s = scr + (8 * c) * 33 + n;
        u32x4 o; o.x = pk2(s[0 * 33], s[1 * 33]); o.y = pk2(s[2 * 33], s[3 * 33]); o.z = pk2(s[4 * 33], s[5 * 33]); o.w = pk2(s[6 * 33], s[7 * 33]);
        *(u32x4*)(dst + (size_t)(n0 + n) * dst_ld + dst_koff + k0 + 8 * c) = o; }
    asm volatile("s_waitcnt lgkmcnt(0)" ::: "memory");
}
struct WMat { const float* src; const float* gain; int K, N, dst_ld, dst_koff; size_t dst_off; };
__device__ __forceinline__ void convert_layer_weights(const Ctx& c, int l) {
    bf16_t* wb = c.wbuf(l);
    const float* const* in = c.in;
    constexpr int NM = 11;
    for (int mi = 0; mi < NM; ++mi) {
        WMat w;
        switch (mi) {
        case 0: w = {in[I_W_IN] + (size_t)l * 1024 * INCOLS, in[I_NORM_MIX] + l * 1024, 1024, INCOLS, 1024, 0, OW_IN}; break;
        case 1: w = {in[I_W_GLU] + (size_t)l * 512 * 512, nullptr, 512, 512, 512, 0, OW_GLU}; break;
        case 2: w = {in[I_W_UQ] + (size_t)l * 256 * 768, in[I_Q_NORM] + l * 256, 256, 768, 256, 0, OW_UQ}; break;
        case 3: w = {in[I_W_UKV] + (size_t)l * 128 * 1024, in[I_KV_NORM] + l * 128, 128, 1024, 128, 0, OW_UKV}; break;
        case 4: w = {in[I_W_OUT] + (size_t)l * 1024 * 1024, in[I_ON_SSM] + l * 512, 512, 1024, 1024, 0, OW_OUT}; break;
        case 5: w = {in[I_W_OUT] + (size_t)l * 1024 * 1024 + (size_t)512 * 1024, in[I_ON_MLA] + l * 512, 512, 1024, 1024, 512, OW_OUT}; break;
        case 6: w = {in[I_MEM_WQ] + (size_t)l * 1024 * 256, in[I_NMEM_Q] + l * 1024, 1024, 256, 1024, 0, OW_MQ}; break;
        case 7: w = {in[I_MEM_WKV] + (size_t)l * 1024 * 512, in[I_NMEM_KV] + l * 1024, 1024, 512, 1024, 0, OW_MKV}; break;
        case 8: w = {in[I_MEM_WO] + (size_t)l * 256 * 1024, nullptr, 256, 1024, 256, 0, OW_MO}; break;
        case 9: w = {in[I_W1] + (size_t)l * 1024 * 4096, in[I_NORM_MLP] + l * 1024, 1024, 4096, 1024, 0, OW_1}; break;
        default: w = {in[I_W2] + (size_t)l * 4096 * 1024, nullptr, 4096, 1024, 4096, 0, OW_2}; break;
        }
        const int nnb = w.N / 32, nit = (w.K / 64) * nnb;
        for (int it = c.gw; it < nit; it += c.ngw) wconv_item(w.src, w.N, w.gain, wb + w.dst_off, w.dst_ld, w.dst_koff, it / nnb, it % nnb, c.scr, c.lane);
    }
    { u32x4* z = (u32x4*)(wb + OW_IN + (size_t)INCOLS * 1024); const int n16 = (INPAD - INCOLS) * 1024 * 2 / 16;
      for (int i = c.gw * 64 + c.lane; i < n16; i += c.ngw * 64) z[i] = (u32x4){0u, 0u, 0u, 0u}; }
}

__device__ __forceinline__ void s5_tables(const Ctx& c, float* lds  ) {
    float* apr = lds;
    float* api = lds + 17 * 64;
    float* bbr = lds + 34 * 64;
    float* bbi = bbr + 64 * 16;
    float* cr = bbi + 64 * 16;
    float* ci = cr + 16 * 64;
    const float* const* in = c.in;
    for (int lg = blockIdx.x; lg < DEPTH * NGRP; lg += gridDim.x) {
        __syncthreads();
        const int tid = c.tid;
        if (tid < 64) {
            const int p = tid;
            const float lre = in[I_LAM_RE][lg * 64 + p], lim = in[I_LAM_IM][lg * 64 + p];
            const float step = expf(in[I_LOG_STEP][lg]);
            const float x = lre * step, th = lim * step;
            for (int tau = 0; tau <= 16; ++tau) { const float mg = expf(x * (float)tau); const float an = th * (float)tau; apr[tau * 64 + p] = mg * cosf(an); api[tau * 64 + p] = mg * sinf(an); }
            const float ex1 = expm1f(x), cs = cosf(th), sn = sinf(th), sh = sinf(0.5f * th);
            const float am1r = ex1 * cs - 2.f * sh * sh, am1i = (ex1 + 1.f) * sn;
            const float den = lre * lre + lim * lim;
            const float cfr = (am1r * lre + am1i * lim) / den, cfi = (am1i * lre - am1r * lim) / den;
            for (int h = 0; h < 16; ++h) { const float br = in[I_B_RE][(size_t)(lg * 64 + p) * 16 + h], bi = in[I_B_IM][(size_t)(lg * 64 + p) * 16 + h];
                bbr[p * 16 + h] = cfr * br - cfi * bi; bbi[p * 16 + h] = cfr * bi + cfi * br; }
            float* a16 = c.p<float>(WS_A16) + (size_t)(lg * 64 + p) * 2;
            const float m16 = expf(x * 16.f); a16[0] = m16 * cosf(th * 16.f); a16[1] = m16 * sinf(th * 16.f);
        }
        for (int i = tid; i < 16 * 64; i += blockDim.x) { cr[i] = in[I_C_RE][(size_t)lg * 1024 + i]; ci[i] = in[I_C_IM][(size_t)lg * 1024 + i]; }
        __syncthreads();
        bf16_t* kt = c.p<bf16_t>(WS_KTAB) + (size_t)lg * 4096;
        for (int e = tid; e < 4096; e += blockDim.x) {
            const int tau = e >> 8, h = (e >> 4) & 15, hp = e & 15; float s = 0.f;
            for (int p = 0; p < 64; ++p) { const float ar = apr[tau * 64 + p], ai = api[tau * 64 + p], c_r = cr[h * 64 + p], c_i = ci[h * 64 + p];
                const float zr = c_r * ar - c_i * ai, zi = c_r * ai + c_i * ar; s += zr * bbr[p * 16 + hp] - zi * bbi[p * 16 + hp]; }
            kt[e] = (bf16_t)f2bf(s);
        }
        bf16_t* we = c.p<bf16_t>(WS_WE) + (size_t)lg * 128 * 256;
        for (int e = tid; e < 128 * 256; e += blockDim.x) {
            const int i = e >> 8, k = e & 255, part = i >> 6, p = i & 63, s_ = k >> 4, hp = k & 15;
            const float ar = apr[(15 - s_) * 64 + p], ai = api[(15 - s_) * 64 + p], br = bbr[p * 16 + hp], bi = bbi[p * 16 + hp];
            we[e] = (bf16_t)f2bf(part == 0 ? (ar * br - ai * bi) : (ar * bi + ai * br));
        }
        bf16_t* wy = c.p<bf16_t>(WS_WY) + (size_t)lg * 256 * 128;
        for (int e = tid; e < 256 * 128; e += blockDim.x) {
            const int n = e >> 7, i = e & 127, t = n >> 4, h = n & 15, part = i >> 6, p = i & 63;
            const float ar = apr[(t + 1) * 64 + p], ai = api[(t + 1) * 64 + p], c_r = cr[h * 64 + p], c_i = ci[h * 64 + p];
            wy[e] = (bf16_t)f2bf(part == 0 ? (c_r * ar - c_i * ai) : -(c_r * ai + c_i * ar));
        }
    }
    __syncthreads();
}


namespace pg8 {
constexpr int BM = 256, BK = 64, HALF = 128, HTB = HALF * BK * 2, STAGE_BYTES = 8 * HTB, NXCD = 8, WGM = 8;
__host__ __device__ __forceinline__ int lds_byte(int r, int c) { const int st = (r >> 4) * 2 + (c >> 5), rr = r & 15, cc = c & 31, ob = rr * 64 + cc * 2; return st * 1024 + (ob ^ (((ob >> 9) & 1) << 5)); }
__host__ __device__ __forceinline__ void stage_rc(int b, int& R, int& C) { const int st = b / 1024, sb = b % 1024, swz = sb ^ (((sb >> 9) & 1) << 5); R = (st >> 1) * 16 + swz / 64; C = (st & 1) * 32 + (swz % 64) / 2; }
__host__ __device__ __forceinline__ int perm32(int rho) { const int n = rho >> 4, i = rho & 15; return 8 * (i >> 2) + 4 * n + (i & 3); }
struct Unit { int pm, pn; };
struct Gemm { const bf16_t* A; const bf16_t* Bt; int M, N, K; };
struct StaticOrder {
    int nM, nN, nwg, G, c;
    __device__ void init(int M, int N, int G_, int c_) { nM = M / BM; nN = N / BM; nwg = nM * nN; G = G_; c = c_; }
    __device__ bool next(int i, Unit& u) const {
        const long L = (long)i * G + c; if (L >= nwg) return false;
        int wgid = (int)L; { const int q = nwg / NXCD, r = nwg % NXCD, xcd = wgid % NXCD, off = wgid / NXCD; wgid = (xcd < r ? xcd * (q + 1) : r * (q + 1) + (xcd - r) * q) + off; }
        const int nig = WGM * nN, gid = wgid / nig, fm = gid * WGM, gsz = (nM - fm) < WGM ? (nM - fm) : WGM;
        u.pm = fm + ((wgid % nig) % gsz); u.pn = (wgid % nig) / gsz; return true;
    }
};
template <class Epi, bool ALIGN_EPI, int MIDK>
__device__ __forceinline__ void gemm_phase(PG8_LAS unsigned char* lds, const Gemm g, const StaticOrder& S, const Epi& E, const int tid) {
    const int wid = __builtin_amdgcn_readfirstlane(tid >> 6), lane = tid & 63, wr = wid >> 2, wc = wid & 3, fr = lane & 15, fq = lane >> 4;
    const int K = g.K, nt = K / BK;
    unsigned voffA[2], voffB[2];
#pragma unroll
    for (int i = 0; i < 2; ++i) { int R, C; stage_rc(tid * 16 + i * 8192, R, C); const int Rb = Epi::PERM ? ((R & ~31) + perm32(R & 31)) : R;
        voffA[i] = (unsigned)(R * K + C) * 2u; voffB[i] = (unsigned)(Rb * K + C) * 2u; }
    const size_t kstep = (size_t)(BK * 2);
    const size_t hstep = (size_t)HALF * K * 2;
    const size_t tstep = 2 * hstep;
    const unsigned ldsw = (unsigned)wid * 1024u;
    const int aoff = lds_byte(wr * 64 + fr, fq * 8), boff = lds_byte(wc * 32 + fr, fq * 8);
#define PG8_SA(b, h) (((b) * 2 + (h)) * HTB)
#define PG8_SB(b, h) ((4 + (b) * 2 + (h)) * HTB)
#define PG8_STAGE(bufoff, gbase, voff) do { _Pragma("unroll") for (int _i = 0; _i < 2; ++_i) \
        __builtin_amdgcn_global_load_lds((const unsigned*)((const char*)(gbase) + (voff)[_i]), (PG8_LAS unsigned*)(lds + (bufoff) + ldsw + _i * 8192), 16, 0, 0); } while (0)
#define PG8_LDA(dst, b, h) do { _Pragma("unroll") for (int m = 0; m < 4; ++m) _Pragma("unroll") for (int k = 0; k < 2; ++k) dst[m][k] = *(const PG8_LAS bf16x8*)(lds + PG8_SA(b, h) + aoff + m * 2048 + k * 1024); } while (0)
#define PG8_LDB(dst, b, h) do { _Pragma("unroll") for (int n = 0; n < 2; ++n) _Pragma("unroll") for (int k = 0; k < 2; ++k) dst[n][k] = *(const PG8_LAS bf16x8*)(lds + PG8_SB(b, h) + boff + n * 2048 + k * 1024); } while (0)
#define PG8_MMA(ai, bj, At, Bt) do { __builtin_amdgcn_s_setprio(1); _Pragma("unroll") for (int m = 0; m < 4; ++m) _Pragma("unroll") for (int n = 0; n < 2; ++n) _Pragma("unroll") for (int k = 0; k < 2; ++k) \
        acc[ai][bj][m][n] = __builtin_amdgcn_mfma_f32_16x16x32_bf16(Bt[n][k], At[m][k], acc[ai][bj][m][n], 0, 0, 0); __builtin_amdgcn_s_setprio(0); } while (0)
#define PG8_WAIT_V(n) asm volatile("s_waitcnt vmcnt(" #n ")" ::: "memory")
#define PG8_WAIT_L(n) asm volatile("s_waitcnt lgkmcnt(" #n ")" ::: "memory")
#define PG8_BAR __builtin_amdgcn_s_barrier()
#define PG8_SCHED __builtin_amdgcn_sched_barrier(0)
    Unit cur, nxt; int ui = 0;
    if (!S.next(0, cur)) return;
    f32x4 acc[2][2][4][2];
#pragma unroll
    for (int a = 0; a < 2; ++a)
#pragma unroll
        for (int b = 0; b < 2; ++b)
#pragma unroll
            for (int m = 0; m < 4; ++m)
#pragma unroll
                for (int n = 0; n < 2; ++n) acc[a][b][m][n] = (f32x4){0.f, 0.f, 0.f, 0.f};
    bf16x8 At[4][2], B0[2][2], B1[2][2];
    const char* cA = (const char*)g.A + (size_t)cur.pm * tstep; const char* cB = (const char*)g.Bt + (size_t)cur.pn * tstep;
    PG8_STAGE(PG8_SB(0, 0), cB, voffB); PG8_STAGE(PG8_SB(0, 1), cB + hstep, voffB); PG8_STAGE(PG8_SA(0, 0), cA, voffA); PG8_STAGE(PG8_SA(0, 1), cA + hstep, voffA);
    if (wr == 1) PG8_BAR;
    PG8_WAIT_V(2); PG8_BAR;
    PG8_STAGE(PG8_SB(1, 0), cB + kstep, voffB); PG8_STAGE(PG8_SA(1, 0), cA + kstep, voffA); PG8_STAGE(PG8_SB(1, 1), cB + hstep + kstep, voffB);
    PG8_WAIT_V(6); PG8_BAR;
    for (;;) {
        const bool has_next = S.next(ui + 1, nxt);
        const char* nA = has_next ? (const char*)g.A + (size_t)nxt.pm * tstep : cA; const char* nB = has_next ? (const char*)g.Bt + (size_t)nxt.pn * tstep : cB;
        constexpr int NSEG = (MIDK > 0) ? 2 : 1;
#pragma unroll 1
        for (int sg = 0; sg < NSEG; ++sg) {
        if constexpr (MIDK > 0) { if (sg == 1) E.mid(acc, cur, wr, fr); }
        const int t_lo = (MIDK > 0) ? sg * MIDK : 0, t_hi = (MIDK > 0) ? (sg == 0 ? MIDK : nt) : nt;
#pragma unroll 1
        for (int t = t_lo; t < t_hi; t += 2) {
            const bool last = (t == nt - 2);
            const char* a1 = cA + (size_t)(t + 1) * kstep;
            const char* a2 = last ? nA : cA + (size_t)(t + 2) * kstep; const char* b2 = last ? nB : cB + (size_t)(t + 2) * kstep;
            const char* a3 = a2 + kstep; const char* b3 = b2 + kstep;
            PG8_LDB(B0, 0, 0); PG8_LDB(B1, 0, 1); PG8_SCHED; PG8_LDA(At, 0, 0); PG8_STAGE(PG8_SA(1, 1), a1 + hstep, voffA);
            PG8_WAIT_V(8); PG8_WAIT_L(0); PG8_BAR; PG8_MMA(0, 0, At, B0); PG8_MMA(0, 1, At, B1); PG8_BAR; PG8_SCHED;
            PG8_LDA(At, 0, 1); PG8_STAGE(PG8_SB(0, 0), b2, voffB); PG8_STAGE(PG8_SB(0, 1), b2 + hstep, voffB); PG8_STAGE(PG8_SA(0, 0), a2, voffA);
            PG8_WAIT_V(8); PG8_WAIT_L(0); PG8_BAR; PG8_MMA(1, 0, At, B0); PG8_MMA(1, 1, At, B1); PG8_BAR; PG8_SCHED;
            PG8_LDB(B0, 1, 0); PG8_LDB(B1, 1, 1); PG8_SCHED; PG8_LDA(At, 1, 0); PG8_STAGE(PG8_SA(0, 1), a2 + hstep, voffA);
            PG8_WAIT_V(8); PG8_WAIT_L(0); PG8_BAR; PG8_MMA(0, 0, At, B0); PG8_MMA(0, 1, At, B1); PG8_BAR; PG8_SCHED;
            PG8_LDA(At, 1, 1); PG8_STAGE(PG8_SB(1, 0), b3, voffB); PG8_STAGE(PG8_SB(1, 1), b3 + hstep, voffB); PG8_STAGE(PG8_SA(1, 0), a3, voffA);
            PG8_WAIT_V(8); PG8_WAIT_L(0); PG8_BAR; PG8_MMA(1, 0, At, B0); PG8_MMA(1, 1, At, B1); PG8_BAR; PG8_SCHED;
        }
        }
        if constexpr (ALIGN_EPI) { if (wr == 0) PG8_BAR; }
        E(acc, cur, wr, wc, fr, fq);
        if (!has_next) break;
#pragma unroll
        for (int a = 0; a < 2; ++a)
#pragma unroll
            for (int b = 0; b < 2; ++b)
#pragma unroll
                for (int m = 0; m < 4; ++m)
#pragma unroll
                    for (int n = 0; n < 2; ++n) acc[a][b][m][n] = (f32x4){0.f, 0.f, 0.f, 0.f};
        cur = nxt; cA = nA; cB = nB; ++ui;
        if constexpr (ALIGN_EPI) { if (wr == 1) PG8_BAR; }
    }
    PG8_WAIT_V(0);
    if constexpr (!ALIGN_EPI) { if (wr == 0) PG8_BAR; }
    PG8_BAR;
#undef PG8_SA
#undef PG8_SB
#undef PG8_STAGE
#undef PG8_LDA
#undef PG8_LDB
#undef PG8_MMA
#undef PG8_WAIT_V
#undef PG8_WAIT_L
#undef PG8_BAR
#undef PG8_SCHED
}
}

__device__ __forceinline__ float sum16(const float* p) {
    const f32x4 a = *(const f32x4*)p, b = *(const f32x4*)(p + 4), c = *(const f32x4*)(p + 8), d = *(const f32x4*)(p + 12);
    return ((a[0] + a[1]) + (a[2] + a[3])) + ((b[0] + b[1]) + (b[2] + b[3])) + (((c[0] + c[1]) + (c[2] + c[3])) + ((d[0] + d[1]) + (d[2] + d[3])));
}
__device__ __forceinline__ float sum8(const float* p) {
    const f32x4 a = *(const f32x4*)p, b = *(const f32x4*)(p + 4);
    return ((a[0] + a[1]) + (a[2] + a[3])) + ((b[0] + b[1]) + (b[2] + b[3]));
}
__device__ __forceinline__ u32x4 pack8(f32x4 a, f32x4 b) { u32x4 w; w.x = pk2(a[0], a[1]); w.y = pk2(a[2], a[3]); w.z = pk2(b[0], b[1]); w.w = pk2(b[2], b[3]); return w; }

struct EpiInproj { static constexpr bool PERM = true;
    const float* ssp; bf16_t *U, *CQ, *CKV;
    __device__ __forceinline__ void operator()(const f32x4 (&acc)[2][2][4][2], const pg8::Unit& u, int wr, int wc, int fr, int fq) const {
#pragma unroll
        for (int ai = 0; ai < 2; ++ai)
#pragma unroll
            for (int m = 0; m < 4; ++m) {
                const int row = u.pm * 256 + ai * 128 + wr * 64 + m * 16 + fr;
                const float rstd = 1.0f / sqrtf(sum16(ssp + (size_t)row * 16) * (1.f / 1024.f) + EPS);
#pragma unroll
                for (int bj = 0; bj < 2; ++bj) {
                    const int col = u.pn * 256 + bj * 128 + wc * 32 + 8 * fq;
                    if (col >= INCOLS) continue;
                    const u32x4 w = pack8(acc[ai][bj][m][0] * rstd, acc[ai][bj][m][1] * rstd);
                    if (col < 512) *(u32x4*)(U + (size_t)row * 512 + col) = w;
                    else if (col < 768) *(u32x4*)(CQ + (size_t)row * 256 + (col - 512)) = w;
                    else *(u32x4*)(CKV + (size_t)row * CKVP + (col - 768)) = w;
                }
            }
    }
};
struct EpiRelu2 { static constexpr bool PERM = true;
    const float* ssp; bf16_t* HB;
    __device__ __forceinline__ void operator()(const f32x4 (&acc)[2][2][4][2], const pg8::Unit& u, int wr, int wc, int fr, int fq) const {
#pragma unroll
        for (int ai = 0; ai < 2; ++ai)
#pragma unroll
            for (int m = 0; m < 4; ++m) {
                const int row = u.pm * 256 + ai * 128 + wr * 64 + m * 16 + fr;
                const float rstd = 1.0f / sqrtf(sum16(ssp + (size_t)row * 16) * (1.f / 1024.f) + EPS);
#pragma unroll
                for (int bj = 0; bj < 2; ++bj) {
                    const int col = u.pn * 256 + bj * 128 + wc * 32 + 8 * fq;
                    f32x4 v0 = acc[ai][bj][m][0] * rstd, v1 = acc[ai][bj][m][1] * rstd;
#pragma unroll
                    for (int r = 0; r < 4; ++r) { const float t0 = fmaxf(v0[r], 0.f), t1 = fmaxf(v1[r], 0.f); v0[r] = t0 * t0; v1[r] = t1 * t1; }
                    *(u32x4*)(HB + (size_t)row * DFF + col) = pack8(v0, v1);
                }
            }
    }
};
template <bool TWOSEG> struct EpiResid { static constexpr bool PERM = false;
    const float* xold; float* out; bf16_t* XB; float* ssp; const PG8_LAS float* tab;
    __device__ __forceinline__ void mid(f32x4 (&acc)[2][2][4][2], const pg8::Unit& u, int wr, int fr) const {
#pragma unroll
        for (int ai = 0; ai < 2; ++ai)
#pragma unroll
            for (int m = 0; m < 4; ++m) { const float f = tab[(ai * 128 + wr * 64 + m * 16 + fr) * 2];
#pragma unroll
                for (int bj = 0; bj < 2; ++bj)
#pragma unroll
                    for (int n = 0; n < 2; ++n) acc[ai][bj][m][n] = acc[ai][bj][m][n] * f; }
    }
    __device__ __forceinline__ void operator()(const f32x4 (&acc)[2][2][4][2], const pg8::Unit& u, int wr, int wc, int fr, int fq) const {
#pragma unroll
        for (int ai = 0; ai < 2; ++ai)
#pragma unroll
            for (int m = 0; m < 4; ++m) {
                const int row = u.pm * 256 + ai * 128 + wr * 64 + m * 16 + fr;
                float sc = 1.f; if (TWOSEG) sc = tab[(ai * 128 + wr * 64 + m * 16 + fr) * 2 + 1];
                float ps = 0.f;
#pragma unroll
                for (int bj = 0; bj < 2; ++bj)
#pragma unroll
                    for (int n = 0; n < 2; ++n) {
                        const int col = u.pn * 256 + bj * 128 + wc * 32 + 16 * n + 4 * fq;
                        const f32x4 xo = *(const f32x4*)(xold + (size_t)row * DM + col); const f32x4 xn = xo + acc[ai][bj][m][n] * sc;
                        *(f32x4*)(out + (size_t)row * DM + col) = xn; *(u32x2*)(XB + (size_t)row * DM + col) = pack4(xn);
                        ps += (xn[0] * xn[0] + xn[1] * xn[1]) + (xn[2] * xn[2] + xn[3] * xn[3]);
                    }
                ps = red4(ps);
                if (fq == 0) ssp[(size_t)row * 16 + u.pn * 4 + wc] = ps;
                asm volatile("" ::: "memory");
            }
    }
};

__device__ __forceinline__ void rows_to_bf16(const Ctx& c, const float* src, bf16_t* dst, int nrows) {
    for (int r = c.gw; r < nrows; r += c.ngw) {
        const f32x4* xr = (const f32x4*)(src + (size_t)r * 1024) + c.lane; u32x2* o = (u32x2*)(dst + (size_t)r * 1024) + c.lane;
#pragma unroll
        for (int j = 0; j < 4; ++j) o[64 * j] = pack4(xr[64 * j]);
    }
}
__device__ __forceinline__ void phase_prologue(const Ctx& c) {
    {
        const float* src = c.in[I_X]; bf16_t* dst = c.p<bf16_t>(WS_XB); float* ssp = c.p<float>(WS_SSP);
        for (int r = c.gw; r < T_; r += c.ngw) {
            const f32x4* xr = (const f32x4*)(src + (size_t)r * 1024) + c.lane; u32x2* o = (u32x2*)(dst + (size_t)r * 1024) + c.lane; float ps = 0.f;
#pragma unroll
            for (int j = 0; j < 4; ++j) { const f32x4 v = xr[64 * j]; o[64 * j] = pack4(v); ps += (v[0] * v[0] + v[1] * v[1]) + (v[2] * v[2] + v[3] * v[3]); }
#pragma unroll
            for (int o_ = 1; o_ < 64; o_ <<= 1) ps += __shfl_xor(ps, o_);
            if (c.lane < 16) ssp[(size_t)r * 16 + c.lane] = (c.lane == 0) ? ps : 0.f;
        }
    }
    rows_to_bf16(c, c.in[I_MEM], c.p<bf16_t>(WS_MEMB), BATCH * NMEM);
    { const int* pos = (const int*)c.in[I_POS]; float* rc = c.p<float>(WS_ROPE_COS); float* rs = c.p<float>(WS_ROPE_SIN);
      for (int i = c.gw * 64 + c.lane; i < T_ * 16; i += c.ngw * 64) { const int t = i >> 4, j = i & 15;
          const float inv = exp2f(-(float)j * (13.287712379549449f / 16.f));
          const float ang = (float)pos[t] * inv; rc[i] = cosf(ang); rs[i] = sinf(ang); } }
    s5_tables(c, c.scr - c.wid * 64 * 33);
    convert_layer_weights(c, 0);
    convert_layer_weights(c, 1);
}

__device__ __forceinline__ void phase_inproj(const Ctx& c, int l) {
    pg8::Gemm g{c.p<bf16_t>(WS_XB), c.wbuf(l) + OW_IN, T_, INPAD, 1024}; pg8::StaticOrder S; S.init(T_, INPAD, gridDim.x, blockIdx.x);
    EpiInproj E{c.p<float>(WS_SSP), c.p<bf16_t>(WS_U), c.p<bf16_t>(WS_CQ), c.p<bf16_t>(WS_CKV)};
    pg8::gemm_phase<EpiInproj, true, 0>(c.lds, g, S, E, c.tid);
}

__device__ __forceinline__ void phase_upproj(const Ctx& c, int l) {
    const float* rc = c.p<float>(WS_ROPE_COS); const float* rs = c.p<float>(WS_ROPE_SIN);
    const int fr = c.fr, fq = c.fq;
    {
        const bf16_t* CQ = c.p<bf16_t>(WS_CQ); const bf16_t* W = c.wbuf(l) + OW_UQ; bf16_t* Q = c.p<bf16_t>(WS_Q);
        const float* qg = c.in[I_Q_GAIN] + l * QKD; const float QS = LOG2E / sqrtf((float)QKD);
        constexpr int NWU = (T_ / 32) * MLAH;
        for (int wu = c.gw; wu < NWU; wu += c.ngw) {
            const int rt = wu / MLAH, h = wu % MLAH;
            f32x4 acc[2][6]; zero_acc(acc); float ss[2] = {0.f, 0.f};
            gemm_frag_loop<2, 6, true>(acc, CQ + (size_t)rt * 32 * 256, 256, W + (size_t)h * QKD * 256, 256, 256, fr, fq, ss);
#pragma unroll
            for (int m = 0; m < 2; ++m) {
                const int tok = rt * 32 + 16 * m + fr;
                const float rstd = 1.0f / sqrtf(red4(ss[m]) * (1.f / 256.f) + EPS);
                float hs = 0.f;
#pragma unroll
                for (int n = 0; n < 6; ++n) { acc[m][n] = acc[m][n] * rstd; hs += acc[m][n][0] * acc[m][n][0] + acc[m][n][1] * acc[m][n][1] + acc[m][n][2] * acc[m][n][2] + acc[m][n][3] * acc[m][n][3]; }
                const float rh = QS / sqrtf(red4(hs) * (1.f / 96.f) + EPS);
#pragma unroll
                for (int n = 0; n < 6; ++n) { const f32x4 g = *(const f32x4*)(qg + 16 * n + 4 * fq); acc[m][n] = acc[m][n] * g * rh; }
                const f32x4 cs = *(const f32x4*)(rc + (size_t)tok * 16 + 4 * fq), sn = *(const f32x4*)(rs + (size_t)tok * 16 + 4 * fq);
                const f32x4 x1 = acc[m][4], x2 = acc[m][5];
                acc[m][4] = x1 * cs - x2 * sn; acc[m][5] = x2 * cs + x1 * sn;
#pragma unroll
                for (int n = 0; n < 6; ++n) *(u32x2*)(Q + (size_t)tok * 768 + h * QKD + 16 * n + 4 * fq) = pack4(acc[m][n]);
            }
        }
    }
    {
        const bf16_t* CKV = c.p<bf16_t>(WS_CKV); const bf16_t* W = c.wbuf(l) + OW_UKV; bf16_t* K = c.p<bf16_t>(WS_K); bf16_t* VT = c.p<bf16_t>(WS_VT);
        const float* kg = c.in[I_K_GAIN] + l * QKD;
        constexpr int NWU = (T_ / 32) * MLAH;
        for (int wu = c.gw; wu < NWU; wu += c.ngw) {
            const int rt = wu / MLAH, h = wu % MLAH;
            f32x4 acc[2][8]; zero_acc(acc); float ss[2] = {0.f, 0.f};
            gemm_frag_loop<2, 8, true>(acc, CKV + (size_t)rt * 32 * CKVP, CKVP, W + (size_t)h * 128 * 128, 128, 128, fr, fq, ss);
#pragma unroll
            for (int m = 0; m < 2; ++m) {
                const int tok = rt * 32 + 16 * m + fr; const int b = tok / SEQ, s = tok % SEQ;
                const float rstd = 1.0f / sqrtf(red4(ss[m]) * (1.f / 128.f) + EPS);
                const f32x4 x1 = unpack4(*(const u32x2*)(CKV + (size_t)tok * CKVP + 128 + 4 * fq)), x2 = unpack4(*(const u32x2*)(CKV + (size_t)tok * CKVP + 144 + 4 * fq));
                float hs = x1[0] * x1[0] + x1[1] * x1[1] + x1[2] * x1[2] + x1[3] * x1[3] + x2[0] * x2[0] + x2[1] * x2[1] + x2[2] * x2[2] + x2[3] * x2[3];
#pragma unroll
                for (int n = 0; n < 8; ++n) acc[m][n] = acc[m][n] * rstd;
#pragma unroll
                for (int n = 0; n < 4; ++n) hs += acc[m][n][0] * acc[m][n][0] + acc[m][n][1] * acc[m][n][1] + acc[m][n][2] * acc[m][n][2] + acc[m][n][3] * acc[m][n][3];
                const float rk = 1.0f / sqrtf(red4(hs) * (1.f / 96.f) + EPS);
#pragma unroll
                for (int n = 0; n < 4; ++n) { const f32x4 g = *(const f32x4*)(kg + 16 * n + 4 * fq);
                    *(u32x2*)(K + (size_t)tok * 768 + h * QKD + 16 * n + 4 * fq) = pack4(acc[m][n] * g * rk); }
                const f32x4 g1 = *(const f32x4*)(kg + 64 + 4 * fq), g2 = *(const f32x4*)(kg + 80 + 4 * fq);
                const f32x4 a1 = x1 * g1 * rk, a2 = x2 * g2 * rk;
                const f32x4 cs = *(const f32x4*)(rc + (size_t)tok * 16 + 4 * fq), sn = *(const f32x4*)(rs + (size_t)tok * 16 + 4 * fq);
                *(u32x2*)(K + (size_t)tok * 768 + h * QKD + 64 + 4 * fq) = pack4(a1 * cs - a2 * sn);
                *(u32x2*)(K + (size_t)tok * 768 + h * QKD + 80 + 4 * fq) = pack4(a2 * cs + a1 * sn);
#pragma unroll
                for (int n = 4; n < 8; ++n)
#pragma unroll
                    for (int r = 0; r < 4; ++r) VT[((size_t)(b * MLAH + h) * VD + 16 * (n - 4) + 4 * fq + r) * SEQ + s] = (bf16_t)f2bf(acc[m][n][r]);
            }
        }
    }
    {
        const bf16_t* U = c.p<bf16_t>(WS_U); const bf16_t* WE = c.p<bf16_t>(WS_WE) + (size_t)l * NGRP * 128 * 256; float* E = c.p<float>(WS_E);
        constexpr int NWU = BATCH * NGRP * (NCH / 16);
        for (int wu = c.gw; wu < NWU; wu += c.ngw) {
            const int cgp = wu % (NCH / 16), g = (wu / (NCH / 16)) % NGRP, b = wu / ((NCH / 16) * NGRP);
            f32x4 acc[8];
#pragma unroll
            for (int i = 0; i < 8; ++i) acc[i] = (f32x4){0.f, 0.f, 0.f, 0.f};
            const bf16_t* ub = U + ((size_t)b * SEQ + (size_t)(cgp * 16 + fr) * CH + (fq >> 1)) * 512 + g * 16 + 8 * (fq & 1);
            const bf16_t* wb = WE + (size_t)g * 128 * 256 + (size_t)fr * 256 + 8 * fq;
#pragma unroll
            for (int ks = 0; ks < 8; ++ks) {
                const bf16x8 uf = *(const bf16x8*)(ub + (size_t)(2 * ks) * 512);
#pragma unroll
                for (int it = 0; it < 8; ++it) { const bf16x8 wf = *(const bf16x8*)(wb + (size_t)it * 16 * 256 + 32 * ks); acc[it] = MFMA16(wf, uf, acc[it]); }
            }
            float* eb = E + ((size_t)(b * NGRP + g) * NCH + cgp * 16 + fr) * 128 + 4 * fq;
#pragma unroll
            for (int it = 0; it < 8; ++it) *(f32x4*)(eb + 16 * it) = acc[it];
        }
    }
    {
        const bf16_t* MB = c.p<bf16_t>(WS_MEMB); const bf16_t* W = c.wbuf(l) + OW_MKV; bf16_t* KM = c.p<bf16_t>(WS_KMEM); bf16_t* VMT = c.p<bf16_t>(WS_VMEMT);
        const float* kg = c.in[I_MEM_KG] + l * MEMHD;
        constexpr int NWU = (BATCH * NMEM / 32) * MEMH;
        for (int wu = c.gw; wu < NWU; wu += c.ngw) {
            const int rt = wu / MEMH, h = wu % MEMH;
            f32x4 acc[2][8]; zero_acc(acc); float ss[2] = {0.f, 0.f};
            gemm_frag_loop<2, 8, true>(acc, MB + (size_t)rt * 32 * 1024, 1024, W + (size_t)h * 128 * 1024, 1024, 1024, fr, fq, ss);
#pragma unroll
            for (int m = 0; m < 2; ++m) {
                const int row = rt * 32 + 16 * m + fr; const int b = row / NMEM, key = row % NMEM;
                const float rstd = 1.0f / sqrtf(red4(ss[m]) * (1.f / 1024.f) + EPS);
                float hs = 0.f;
#pragma unroll
                for (int n = 0; n < 8; ++n) acc[m][n] = acc[m][n] * rstd;
#pragma unroll
                for (int n = 0; n < 4; ++n) hs += acc[m][n][0] * acc[m][n][0] + acc[m][n][1] * acc[m][n][1] + acc[m][n][2] * acc[m][n][2] + acc[m][n][3] * acc[m][n][3];
                const float rk = 1.0f / sqrtf(red4(hs) * (1.f / 64.f) + EPS);
#pragma unroll
                for (int n = 0; n < 4; ++n) { const f32x4 g = *(const f32x4*)(kg + 16 * n + 4 * fq);
                    *(u32x2*)(KM + ((size_t)(b * MEMH + h) * NMEM + key) * MEMHD + 16 * n + 4 * fq) = pack4(acc[m][n] * g * rk); }
#pragma unroll
                for (int n = 4; n < 8; ++n)
#pragma unroll
                    for (int r = 0; r < 4; ++r) VMT[((size_t)(b * MEMH + h) * MEMHD + 16 * (n - 4) + 4 * fq + r) * NMEM + key] = (bf16_t)f2bf(acc[m][n][r]);
            }
        }
    }
}

template <int KS, bool CAUSAL>
__device__ __forceinline__ void attn_wave(const bf16_t* qp, int q_ld, const bf16_t* kp, int k_ld, const bf16_t* vp, int v_ld, bf16_t* op, int o_ld, int nkb, int qpos0, int fr, int fq, float* ssout, int ss_ld) {
    bf16x8 qf[KS];
#pragma unroll
    for (int ks = 0; ks < KS; ++ks) qf[ks] = *(const bf16x8*)(qp + (size_t)fr * q_ld + 32 * ks + 8 * fq);
    f32x4 o[4];
#pragma unroll
    for (int d = 0; d < 4; ++d) o[d] = (f32x4){0.f, 0.f, 0.f, 0.f};
    float mrun = -INFINITY, lsum = 0.f;
    const int qpos = qpos0 + fr;
    for (int kb = 0; kb < nkb; ++kb) {
        const int key0 = kb * 32;
        f32x4 sa = (f32x4){0.f, 0.f, 0.f, 0.f}, sb = (f32x4){0.f, 0.f, 0.f, 0.f};
#pragma unroll
        for (int ks = 0; ks < KS; ++ks) {
            const bf16x8 ka = *(const bf16x8*)(kp + (size_t)(key0 + fr) * k_ld + 32 * ks + 8 * fq);
            const bf16x8 kc = *(const bf16x8*)(kp + (size_t)(key0 + 16 + fr) * k_ld + 32 * ks + 8 * fq);
            sa = MFMA16(ka, qf[ks], sa); sb = MFMA16(kc, qf[ks], sb);
        }
        if (CAUSAL) {
#pragma unroll
            for (int r = 0; r < 4; ++r) { const int ka = key0 + 4 * fq + r; if (ka > qpos) sa[r] = -INFINITY; if (ka + 16 > qpos) sb[r] = -INFINITY; }
        }
        float mx = fmaxf(fmaxf(fmaxf(sa[0], sa[1]), fmaxf(sa[2], sa[3])), fmaxf(fmaxf(sb[0], sb[1]), fmaxf(sb[2], sb[3])));
        mx = max4(mx);
        const float mn = fmaxf(mrun, mx); const float alpha = exp2f(mrun - mn); mrun = mn;
        float ps = 0.f;
#pragma unroll
        for (int r = 0; r < 4; ++r) { sa[r] = exp2f(sa[r] - mn); sb[r] = exp2f(sb[r] - mn); ps += sa[r] + sb[r]; }
        lsum = lsum * alpha + ps;
#pragma unroll
        for (int d = 0; d < 4; ++d) o[d] = o[d] * alpha;
        const u32x2 pa = pack4(sa), pb = pack4(sb);
        const bf16x8 pf = __builtin_bit_cast(bf16x8, (u32x4){pa.x, pa.y, pb.x, pb.y});
#pragma unroll
        for (int d = 0; d < 4; ++d) {
            const bf16_t* vr = vp + (size_t)(16 * d + fr) * v_ld + key0 + 4 * fq;
            const u32x2 v0 = *(const u32x2*)vr, v1 = *(const u32x2*)(vr + 16);
            const bf16x8 vf = __builtin_bit_cast(bf16x8, (u32x4){v0.x, v0.y, v1.x, v1.y});
            o[d] = MFMA16(vf, pf, o[d]);
        }
    }
    const float inv = 1.0f / red4(lsum);
    float ps = 0.f;
#pragma unroll
    for (int d = 0; d < 4; ++d) { const f32x4 v = o[d] * inv; *(u32x2*)(op + (size_t)fr * o_ld + 16 * d + 4 * fq) = pack4(v); ps += (v[0] * v[0] + v[1] * v[1]) + (v[2] * v[2] + v[3] * v[3]); }
    if (ssout) { ps = red4(ps); if (fq == 0) ssout[(size_t)fr * ss_ld] = ps; }
}

__device__ __forceinline__ void phase_attn(const Ctx& c, int l, bool do_scan) {
    if (do_scan) {
        float* E = c.p<float>(WS_E); const float* A16 = c.p<float>(WS_A16) + (size_t)l * NGRP * 64 * 2;
        for (int i = blockIdx.x * blockDim.x + c.tid; i < BATCH * NGRP * 64; i += gridDim.x * blockDim.x) {
            const int p = i & 63, bg = i >> 6, g = bg % NGRP;
            const float ar = A16[(g * 64 + p) * 2], ai = A16[(g * 64 + p) * 2 + 1];
            float hr = 0.f, hi = 0.f; float* e = E + (size_t)bg * NCH * 128 + p;
            for (int ch = 0; ch < NCH; ++ch) { const float er = e[0], ei = e[64]; e[0] = hr; e[64] = hi;
                const float nr = ar * hr - ai * hi + er, ni = ar * hi + ai * hr + ei; hr = nr; hi = ni; e += 128; }
        }
    }
    const bf16_t* Q = c.p<bf16_t>(WS_Q); const bf16_t* K = c.p<bf16_t>(WS_K); const bf16_t* VT = c.p<bf16_t>(WS_VT); bf16_t* Y = c.p<bf16_t>(WS_YCAT); float* SSYM = c.p<float>(WS_SSYM);
    for (int u = blockIdx.x; u < 1024; u += gridDim.x) {
        const int i = u >> 8, blk = u & 255, pair = blk >> 3, s = blk & 7;
        const int qt = (i == 0) ? s : (i == 1) ? 15 - s : (i == 2) ? 16 + s : 31 - s;
        const int b = pair >> 3, h = pair & 7;
        const int r0 = qt * 128 + c.wid * 16; const size_t tok0 = (size_t)b * SEQ;
        attn_wave<3, true>(Q + (tok0 + r0) * 768 + h * QKD, 768, K + tok0 * 768 + h * QKD, 768, VT + (size_t)(b * MLAH + h) * VD * SEQ, SEQ,
                           Y + (tok0 + r0) * 1024 + 512 + h * VD, 1024, (r0 + 16 + 31) / 32, r0, c.fr, c.fq, SSYM + (tok0 + r0) * 8 + h, 8);
    }
}

__device__ __forceinline__ float gelu_tanh(float x) { const float z = 0.7978845608028654f * (x + 0.044715f * x * x * x); const float e = __expf(2.f * z); const float th = 1.f - 2.f / (e + 1.f); return 0.5f * x * (1.f + th); }
__device__ __forceinline__ void phase_s5out(const Ctx& c, int l) {
    const int fr = c.fr, fq = c.fq;
    const bf16_t* U = c.p<bf16_t>(WS_U); const float* H = c.p<float>(WS_E); bf16_t* YG = c.p<bf16_t>(WS_YG);
    const bf16_t* KT = c.p<bf16_t>(WS_KTAB) + (size_t)l * NGRP * 4096; const bf16_t* WY = c.p<bf16_t>(WS_WY) + (size_t)l * NGRP * 256 * 128;
    const float* Dv = c.in[I_SSM_D] + l * SSMW;
    constexpr int NWU = BATCH * NGRP * (NCH / 16);
    for (int wu = c.gw; wu < NWU; wu += c.ngw) {
        const int cgp = wu % (NCH / 16), g = (wu / (NCH / 16)) % NGRP, b = wu / ((NCH / 16) * NGRP);
        const size_t tokc = (size_t)b * SEQ + (size_t)(cgp * 16 + fr) * CH;
        bf16x8 uf[8];
#pragma unroll
        for (int sp = 0; sp < 8; ++sp) uf[sp] = *(const bf16x8*)(U + (tokc + 2 * sp + (fq >> 1)) * 512 + g * 16 + 8 * (fq & 1));
        bf16x8 hf[4];
        { const float* hb = H + ((size_t)(b * NGRP + g) * NCH + cgp * 16 + fr) * 128 + 8 * fq;
#pragma unroll
          for (int ks = 0; ks < 4; ++ks) { const f32x4 a = *(const f32x4*)(hb + 32 * ks), bq = *(const f32x4*)(hb + 32 * ks + 4);
              const u32x2 p0 = pack4(a), p1 = pack4(bq); hf[ks] = __builtin_bit_cast(bf16x8, (u32x4){p0.x, p0.y, p1.x, p1.y}); } }
        const bf16_t* kt = KT + (size_t)g * 4096 + fr * 16 + 8 * (fq & 1);
        const bf16_t* wy = WY + (size_t)g * 256 * 128 + (size_t)fr * 128 + 8 * fq;
        const f32x4 dv = *(const f32x4*)(Dv + g * 16 + 4 * fq);
#pragma unroll
        for (int t = 0; t < 16; ++t) {
            f32x4 acc = (f32x4){0.f, 0.f, 0.f, 0.f};
#pragma unroll
            for (int sp = 0; sp <= (t >> 1); ++sp) {
                const int tau = t - 2 * sp - (fq >> 1);
                bf16x8 kf = (bf16x8){0, 0, 0, 0, 0, 0, 0, 0};
                if (tau >= 0) kf = *(const bf16x8*)(kt + tau * 256);
                acc = MFMA16(kf, uf[sp], acc);
            }
#pragma unroll
            for (int ks = 0; ks < 4; ++ks) { const bf16x8 wf = *(const bf16x8*)(wy + (size_t)t * 16 * 128 + 32 * ks); acc = MFMA16(wf, hf[ks], acc); }
            const f32x4 uv = unpack4(*(const u32x2*)(U + (tokc + t) * 512 + g * 16 + 4 * fq));
            f32x4 y = acc + dv * uv;
#pragma unroll
            for (int r = 0; r < 4; ++r) y[r] = gelu_tanh(y[r]);
            *(u32x2*)(YG + (tokc + t) * 512 + g * 16 + 4 * fq) = pack4(y);
        }
    }
}

__device__ __forceinline__ void phase_glu(const Ctx& c, int l) {
    const bf16_t* YG = c.p<bf16_t>(WS_YG); const bf16_t* W = c.wbuf(l) + OW_GLU; bf16_t* YS = c.p<bf16_t>(WS_YCAT); const float* bg = c.in[I_B_GLU] + l * SSMW; float* SSYS = c.p<float>(WS_SSYS);
    constexpr int NCT = SSMW / 64, NWU = (T_ / 64) * NCT;
    for (int wu = c.gw; wu < NWU; wu += c.ngw) {
        const int rt = wu / NCT, ct = wu % NCT;
        f32x4 acc[4][4]; zero_acc(acc); float ss[4];
        gemm_frag_loop<4, 4, false>(acc, YG + (size_t)rt * 64 * 512, 512, W + (size_t)ct * 64 * 512, 512, 512, c.fr, c.fq, ss);
#pragma unroll
        for (int m = 0; m < 4; ++m) {
            const int row = rt * 64 + 16 * m + c.fr; float ps = 0.f;
#pragma unroll
            for (int n = 0; n < 4; ++n) {
                const int col = ct * 64 + 16 * n + 4 * c.fq;
                const f32x4 z = acc[m][n] + *(const f32x4*)(bg + col); const f32x4 y = unpack4(*(const u32x2*)(YG + (size_t)row * 512 + col));
                f32x4 o;
#pragma unroll
                for (int r = 0; r < 4; ++r) { o[r] = y[r] / (1.f + __expf(-z[r])); ps += o[r] * o[r]; }
                *(u32x2*)(YS + (size_t)row * 1024 + col) = pack4(o);
            }
            ps = red4(ps); if (c.fq == 0) SSYS[(size_t)row * 8 + ct] = ps;
        }
    }
}

__device__ __forceinline__ void phase_wout(const Ctx& c, int l) {
    pg8::Gemm g{c.p<bf16_t>(WS_YCAT), c.wbuf(l) + OW_OUT, T_, DM, 1024}; pg8::StaticOrder S; S.init(T_, DM, gridDim.x, blockIdx.x);
    PG8_LAS float* tab = (PG8_LAS float*)(c.lds + pg8::STAGE_BYTES);
    { pg8::Unit u0; if (S.next(0, u0) && c.tid < 256) {
          const int row = u0.pm * 256 + c.tid;
          const float r1 = 1.0f / sqrtf(sum8(c.p<float>(WS_SSYS) + (size_t)row * 8) * (1.f / 512.f) + EPS), r2 = 1.0f / sqrtf(sum8(c.p<float>(WS_SSYM) + (size_t)row * 8) * (1.f / 512.f) + EPS);
          tab[c.tid * 2] = r1 / r2; tab[c.tid * 2 + 1] = r2; } }
    __syncthreads();
    EpiResid<true> E{(l == 0) ? c.in[I_X] : c.out, c.out, c.p<bf16_t>(WS_XB), c.p<float>(WS_SSP), tab};
    pg8::gemm_phase<EpiResid<true>, false, 8>(c.lds, g, S, E, c.tid);
}
__device__ __forceinline__ void phase_gemm_resid(const Ctx& c, const bf16_t* A, const bf16_t* W, int K) {
    pg8::Gemm g{A, W, T_, DM, K}; pg8::StaticOrder S; S.init(T_, DM, gridDim.x, blockIdx.x);
    EpiResid<false> E{c.out, c.out, c.p<bf16_t>(WS_XB), c.p<float>(WS_SSP), nullptr};
    pg8::gemm_phase<EpiResid<false>, false, 0>(c.lds, g, S, E, c.tid);
}
__device__ __forceinline__ void phase_mlp_up(const Ctx& c, int l) {
    pg8::Gemm g{c.p<bf16_t>(WS_XB), c.wbuf(l) + OW_1, T_, DFF, 1024}; pg8::StaticOrder S; S.init(T_, DFF, gridDim.x, blockIdx.x);
    EpiRelu2 E{c.p<float>(WS_SSP), c.p<bf16_t>(WS_HB)};
    pg8::gemm_phase<EpiRelu2, true, 0>(c.lds, g, S, E, c.tid);
}

__device__ __forceinline__ void phase_memq(const Ctx& c, int l) {
    const bf16_t* XB = c.p<bf16_t>(WS_XB); const bf16_t* W = c.wbuf(l) + OW_MQ; bf16_t* MQ = c.p<bf16_t>(WS_MQ); const float* qg = c.in[I_MEM_QG] + l * MEMHD;
    const float QS = LOG2E / 8.f;
    constexpr int NWU = (T_ / 32) * MEMH;
    for (int wu = c.gw; wu < NWU; wu += c.ngw) {
        const int rt = wu / MEMH, h = wu % MEMH;
        f32x4 acc[2][4]; zero_acc(acc); float ss[2] = {0.f, 0.f};
        gemm_frag_loop<2, 4, true>(acc, XB + (size_t)rt * 32 * 1024, 1024, W + (size_t)h * 64 * 1024, 1024, 1024, c.fr, c.fq, ss);
#pragma unroll
        for (int m = 0; m < 2; ++m) {
            const int row = rt * 32 + 16 * m + c.fr;
            const float rstd = 1.0f / sqrtf(red4(ss[m]) * (1.f / 1024.f) + EPS);
            float hs = 0.f;
#pragma unroll
            for (int n = 0; n < 4; ++n) { acc[m][n] = acc[m][n] * rstd; hs += acc[m][n][0] * acc[m][n][0] + acc[m][n][1] * acc[m][n][1] + acc[m][n][2] * acc[m][n][2] + acc[m][n][3] * acc[m][n][3]; }
            const float rh = QS / sqrtf(red4(hs) * (1.f / 64.f) + EPS);
#pragma unroll
            for (int n = 0; n < 4; ++n) { const f32x4 g = *(const f32x4*)(qg + 16 * n + 4 * c.fq); *(u32x2*)(MQ + (size_t)row * 256 + h * 64 + 16 * n + 4 * c.fq) = pack4(acc[m][n] * g * rh); }
        }
    }
}

__device__ __forceinline__ void phase_memattn(const Ctx& c) {
    const bf16_t* MQ = c.p<bf16_t>(WS_MQ); const bf16_t* KM = c.p<bf16_t>(WS_KMEM); const bf16_t* VMT = c.p<bf16_t>(WS_VMEMT); bf16_t* O = c.p<bf16_t>(WS_O);
    constexpr int NU = BATCH * MEMH * (SEQ / 128);
    for (int u = blockIdx.x; u < NU; u += gridDim.x) {
        const int qt = u % (SEQ / 128), h = (u / (SEQ / 128)) % MEMH, b = u / ((SEQ / 128) * MEMH);
        const size_t tok = (size_t)b * SEQ + qt * 128 + c.wid * 16;
        attn_wave<2, false>(MQ + tok * 256 + h * 64, 256, KM + (size_t)(b * MEMH + h) * NMEM * MEMHD, MEMHD, VMT + (size_t)(b * MEMH + h) * MEMHD * NMEM, NMEM,
                            O + tok * 256 + h * 64, 256, NMEM / 32, 0, c.fr, c.fq, nullptr, 0);
    }
}


#define XB_TMO      128
#define XB_XCNT(j)  (256  + 64 * (j))
#define XB_XSUB(j)  (1280 + 64 * (j))
#define XB_XGEN(j)  (2304 + 64 * (j))
#define XB_TOP      3328
#define XB_TOPGEN   3392
#define XCD_BAR_WORDS 3456
#define XB_SPIN_CAP (1u << 20)
__device__ __forceinline__ unsigned xb_ld(unsigned* p)              { return __hip_atomic_load(p, __ATOMIC_RELAXED, __HIP_MEMORY_SCOPE_AGENT); }
__device__ __forceinline__ unsigned xb_add(unsigned* p, unsigned v) { return __hip_atomic_fetch_add(p, v, __ATOMIC_RELAXED, __HIP_MEMORY_SCOPE_AGENT); }
__device__ __forceinline__ unsigned xb_xcc_id() { return (unsigned)__builtin_amdgcn_s_getreg((3 << 11) | 20) & 0xFu; }
#define XB_SPIN(cond, bar) do { unsigned _sp = 0; while (cond) { __builtin_amdgcn_s_sleep(1); \
    if ((++_sp & 255u) == 0u) { if (xb_ld(&(bar)[XB_TMO])) break; if (_sp > XB_SPIN_CAP) { atomicAdd(&(bar)[XB_TMO], 1u); break; } } } } while (0)
struct XcdBarrier { unsigned* bar; unsigned x; volatile PG8_LAS unsigned* st; };
__device__ __forceinline__ XcdBarrier xcd_barrier_post(unsigned* bar, volatile PG8_LAS unsigned* st) {
    XcdBarrier b; b.bar = bar; b.x = xb_xcc_id(); b.st = st;
    if (threadIdx.x == 0) (void)xb_add(&bar[XB_XCNT(b.x)], 1u);
    return b;
}
__device__ __forceinline__ void xcd_barrier_complete(unsigned* bar, unsigned x, unsigned& nloc, unsigned& nx) {
    const unsigned G = gridDim.x * gridDim.y * gridDim.z;
    unsigned sum, cnt, mine, sp = 0u;
    for (;;) {
        sum = 0u; cnt = 0u; mine = 0u;
#pragma unroll
        for (unsigned j = 0; j < 16; ++j) { const unsigned c = xb_ld(&bar[XB_XCNT(j)]); sum += c; cnt += (c > 0u) ? 1u : 0u; mine = (j == x) ? c : mine; }
        if (sum == G) break;
        __builtin_amdgcn_s_sleep(1);
        if ((++sp & 255u) == 0u) { if (xb_ld(&bar[XB_TMO])) break; if (sp > XB_SPIN_CAP) { atomicAdd(&bar[XB_TMO], 1u); break; } }
    }
    nloc = mine > 0u ? mine : 1u; nx = cnt > 0u ? cnt : 1u;
}
__device__ __forceinline__ void xcd_barrier(const XcdBarrier& b) {
    asm volatile("s_waitcnt vmcnt(0)" ::: "memory");
    __syncthreads();
    if (threadIdx.x == 0) {
        unsigned* bar = b.bar;
        __builtin_amdgcn_s_waitcnt(0);
        unsigned nloc = b.st[0], nx = b.st[1];
        if (nloc == 0u) { xcd_barrier_complete(bar, b.x, nloc, nx); b.st[0] = nloc; b.st[1] = nx; }
        const unsigned old = xb_add(&bar[XB_XSUB(b.x)], 1u);
        const unsigned gen = old / nloc;
        if (old + 1u == (gen + 1u) * nloc) {
            __builtin_amdgcn_fence(__ATOMIC_RELEASE, "agent");
            asm volatile("s_waitcnt vmcnt(0)" ::: "memory");
            const unsigned og = xb_add(&bar[XB_TOP], 1u);
            const unsigned tg = og / nx;
            if (og + 1u == (tg + 1u) * nx) xb_add(&bar[XB_TOPGEN], 1u);
            else XB_SPIN(xb_ld(&bar[XB_TOPGEN]) == tg, bar);
            __builtin_amdgcn_fence(__ATOMIC_ACQUIRE, "agent");
            xb_add(&bar[XB_XGEN(b.x)], 1u);
            asm volatile("s_waitcnt vmcnt(0)" ::: "memory");
        } else {
            XB_SPIN(xb_ld(&bar[XB_XGEN(b.x)]) == gen, bar);
            __builtin_amdgcn_fence(__ATOMIC_ACQUIRE, "agent");
            asm volatile("s_waitcnt vmcnt(0)" ::: "memory");
        }
    }
    __syncthreads();
}

constexpr int PH_PER_LAYER = 11, N_PHASES = 1 + DEPTH * PH_PER_LAYER;
constexpr int LDS_BAR_OFF = 131072 + 2048, LDS_BYTES = LDS_BAR_OFF + 64;
constexpr size_t WS_CTL = 0, CTL_BYTES = 16384;
__global__ void __launch_bounds__(512, 2) hymba_fwd(Args a) {
    extern __shared__ __attribute__((aligned(16))) unsigned char lds_raw[];
    float* lds_scr = (float*)lds_raw;
    Ctx c; c.in = a.in; c.out = a.out; c.ws = a.ws;
    c.tid = threadIdx.x; c.lane = c.tid & 63; c.wid = __builtin_amdgcn_readfirstlane(c.tid >> 6);
    c.gw = blockIdx.x * 8 + c.wid; c.ngw = gridDim.x * 8; c.fr = c.lane & 15; c.fq = c.lane >> 4;
    c.scr = lds_scr + c.wid * 64 * 33; c.lds = (PG8_LAS unsigned char*)lds_raw;
#if !MK_PER_PHASE
    volatile PG8_LAS unsigned* bst = (volatile PG8_LAS unsigned*)(c.lds + LDS_BAR_OFF);
    if (threadIdx.x < 2) bst[threadIdx.x] = 0u;
    __syncthreads();
    const XcdBarrier bar = xcd_barrier_post((unsigned*)(a.ws + WS_CTL), bst);
#endif
    for (int ph = a.ph_lo; ph < a.ph_hi; ++ph) {
        { int t_ = threadIdx.x; asm volatile("" : "+v"(t_));
          c.tid = t_; c.lane = t_ & 63; c.fr = c.lane & 15; c.fq = c.lane >> 4; }
#ifndef ONLY_SUB
        if (ph == 0) phase_prologue(c);
#else
        if (ph == 0) { if (ONLY_SUB == 99) phase_prologue(c); }
#endif
        else {
            const int l = (ph - 1) / PH_PER_LAYER, sub = (ph - 1) % PH_PER_LAYER;
#ifdef ONLY_SUB
            if (sub != ONLY_SUB) continue;
#endif
            switch (sub) {
            case 0: _Pragma("unroll 1") for (int r_ = 0; r_ < ((PROBE_MASK & 1) ? 2 : 1); ++r_) phase_inproj(c, l); if (l >= 1 && l + 1 < DEPTH) convert_layer_weights(c, l + 1); break;
            case 1: _Pragma("unroll 1") for (int r_ = 0; r_ < ((PROBE_MASK & 2) ? 2 : 1); ++r_) phase_upproj(c, l); break;
            case 2: _Pragma("unroll 1") for (int r_ = 0; r_ < ((PROBE_MASK & 4) ? 2 : 1); ++r_) phase_attn(c, l, r_ == 0); break;
            case 3: _Pragma("unroll 1") for (int r_ = 0; r_ < ((PROBE_MASK & 8) ? 2 : 1); ++r_) phase_s5out(c, l); break;
            case 4: _Pragma("unroll 1") for (int r_ = 0; r_ < ((PROBE_MASK & 16) ? 2 : 1); ++r_) phase_glu(c, l); break;
            case 5: phase_wout(c, l); break;
            case 6: _Pragma("unroll 1") for (int r_ = 0; r_ < ((PROBE_MASK & 64) ? 2 : 1); ++r_) phase_memq(c, l); break;
            case 7: _Pragma("unroll 1") for (int r_ = 0; r_ < ((PROBE_MASK & 128) ? 2 : 1); ++r_) phase_memattn(c); break;
            case 8: phase_gemm_resid(c, c.p<bf16_t>(WS_O), c.wbuf(l) + OW_MO, 256); break;
            case 9: _Pragma("unroll 1") for (int r_ = 0; r_ < ((PROBE_MASK & 512) ? 2 : 1); ++r_) phase_mlp_up(c, l); break;
            default: phase_gemm_resid(c, c.p<bf16_t>(WS_HB), c.wbuf(l) + OW_2, DFF); break;
            }
        }
#if !MK_PER_PHASE
        if (ph + 1 < a.ph_hi) xcd_barrier(bar);
#endif
    }
}

extern "C" void kernel_launch(void* const* d_in, const int* in_sizes, int n_in, void* d_out, int out_size, void* d_ws, size_t ws_size, hipStream_t stream) {
    static int grid = 0;
    if (grid == 0) {
        if (n_in != N_IN || out_size != T_ * DM || ws_size < WS_END) { fprintf(stderr, "kernel_launch: unexpected shapes n_in %d out %d ws %zu\n", n_in, out_size, ws_size); grid = -1; return; }
        int dev = 0, cus = 0, per_cu = 0;
        (void)hipGetDevice(&dev); (void)hipDeviceGetAttribute(&cus, hipDeviceAttributeMultiprocessorCount, dev);
        (void)hipFuncSetAttribute((const void*)hymba_fwd, hipFuncAttributeMaxDynamicSharedMemorySize, LDS_BYTES);
        (void)hipOccupancyMaxActiveBlocksPerMultiprocessor(&per_cu, (const void*)hymba_fwd, 512, LDS_BYTES);
        if (per_cu < 1) { fprintf(stderr, "kernel_launch: occupancy query returned %d\n", per_cu); grid = -1; return; }
        if (per_cu > 2) per_cu = 2;
        grid = cus * per_cu;
        fprintf(stderr, "kernel_launch: grid %d (%d CUs x %d), ws %zu\n", grid, cus, per_cu, ws_size);
    }
    if (grid < 0) return;
    Args a{};
    for (int i = 0; i < N_IN; ++i) a.in[i] = (const float*)d_in[i];
    a.out = (float*)d_out; a.ws = (unsigned char*)d_ws;
#if MK_PER_PHASE
    for (int ph = 0; ph < N_PHASES; ++ph) { a.ph_lo = ph; a.ph_hi = ph + 1; hipLaunchKernelGGL(hymba_fwd, dim3(grid), dim3(512), LDS_BYTES, stream, a); }
#else
    a.ph_lo = 0; a.ph_hi = N_PHASES;
    (void)hipMemsetAsync((char*)d_ws + WS_CTL, 0, CTL_BYTES, stream);
    void* params[] = {&a};
    hipError_t e = hipLaunchCooperativeKernel((const void*)hymba_fwd, dim3(grid), dim3(512), params, LDS_BYTES, stream);
    if (e != hipSuccess) fprintf(stderr, "kernel_launch: cooperative launch failed: %s (grid %d)\n", hipGetErrorString(e), grid);
#endif
}
```
